# Optimizing an MI355X kernel written in HIP

```python
import math
import jax, jax.numpy as jnp
from jax import lax
import numpy as np

D_MODEL = 2048
BATCH = 2
SEQ = 8192
DEPTH = 1
DEC_BATCH = 128
DEC_SEQ = 1
PAST_LEN = 16384
PAGE_SIZE = 128

PLE_DIM = 256
MIX_WIDTH = D_MODEL
ATTN_WIDTH = MIX_WIDTH // 2
HEAD_DIM = 64
N_HEADS = ATTN_WIDTH // HEAD_DIM
N_KV_HEADS = 4
Q_PER_KV = N_HEADS // N_KV_HEADS
WINDOW = 128
ROPE_DIM = HEAD_DIM // 4
ROPE_THETA = 500000.0
SSM_INNER = MIX_WIDTH - ATTN_WIDTH
SSM_HEAD_DIM = 64
SSM_HEADS = SSM_INNER // SSM_HEAD_DIM
SSM_GROUPS = 4
SSM_HPG = SSM_HEADS // SSM_GROUPS
SSM_STATE = 128
CONV_WIDTH = 4
CONV_DIM = SSM_INNER + 2 * SSM_GROUPS * SSM_STATE
SSD_CHUNK = 128
FFN_HIDDEN = -(-8 * D_MODEL // 768) * 256
Q_DIM = N_HEADS * HEAD_DIM
KV_DIM = N_KV_HEADS * HEAD_DIM
IN_DIM = Q_DIM + 2 * KV_DIM + SSM_INNER + CONV_DIM + SSM_HEADS
RMS_EPS = 1e-6

kernel_name = "hybrid_swa_sink_ssd_step"


def rmsnorm(x, g):
    xf = x.astype(jnp.float32)
    xf = xf * lax.rsqrt(jnp.mean(xf * xf, axis=-1, keepdims=True) + RMS_EPS)
    return xf.astype(x.dtype) * g


def partial_rope(x, pos):
    half = ROPE_DIM // 2
    inv = ROPE_THETA ** (-jnp.arange(half, dtype=jnp.float32) * (2.0 / ROPE_DIM))
    ang = pos.astype(jnp.float32)[:, None] * inv[None, :]
    cos = jnp.cos(ang)[:, None, :].astype(x.dtype)
    sin = jnp.sin(ang)[:, None, :].astype(x.dtype)
    x1, x2, rest = x[..., :half], x[..., half:ROPE_DIM], x[..., ROPE_DIM:]
    return jnp.concatenate([x1 * cos - x2 * sin, x2 * cos + x1 * sin, rest], axis=-1)


def sink_attend(q, k, v, mask, sinks):
    s = jnp.einsum('...qhrd,...khd->...hrqk', q, k).astype(jnp.float32) * (HEAD_DIM ** -0.5)
    s = jnp.where(mask, s, -jnp.inf)
    sink = sinks.astype(jnp.float32).reshape(N_KV_HEADS, Q_PER_KV)[:, :, None, None]
    m = jnp.maximum(jnp.max(s, axis=-1, keepdims=True), sink)
    e = jnp.exp(s - m)
    p = e / (jnp.sum(e, axis=-1, keepdims=True) + jnp.exp(sink - m))
    return jnp.einsum('...hrqk,...khd->...qhrd', p.astype(v.dtype), v)


def window_attention_prompt(q, k, v, sinks):
    b, L = q.shape[:2]
    nb = L // WINDOW
    qb = q.reshape(b, nb, WINDOW, N_KV_HEADS, Q_PER_KV, HEAD_DIM)
    kb = k.reshape(b, nb, WINDOW, N_KV_HEADS, HEAD_DIM)
    vb = v.reshape(b, nb, WINDOW, N_KV_HEADS, HEAD_DIM)
    kk = jnp.concatenate([jnp.concatenate([jnp.zeros_like(kb[:, :1]), kb[:, :-1]], axis=1), kb], axis=2)
    vv = jnp.concatenate([jnp.concatenate([jnp.zeros_like(vb[:, :1]), vb[:, :-1]], axis=1), vb], axis=2)
    blk = jnp.arange(nb)[:, None, None]
    i = jnp.arange(WINDOW)[None, :, None]
    j = jnp.arange(2 * WINDOW)[None, None, :]
    rel = i + WINDOW - j
    mask = (rel >= 0) & (rel < WINDOW) & ((blk > 0) | (j >= WINDOW))
    o = sink_attend(qb, kk, vv, mask[:, None, None], sinks)
    return o.reshape(b, L, Q_DIM), k[:, -WINDOW:], v[:, -WINDOW:]


def window_attention_sample(q, k, v, cache_k, cache_v, sinks):
    T = q.shape[1]
    qg = q.reshape(q.shape[0], T, N_KV_HEADS, Q_PER_KV, HEAD_DIM)
    kk = jnp.concatenate([cache_k, k], axis=1)
    vv = jnp.concatenate([cache_v, v], axis=1)
    qpos = PAST_LEN + jnp.arange(T)
    kpos = jnp.concatenate([PAST_LEN - WINDOW + jnp.arange(WINDOW), PAST_LEN + jnp.arange(T)])
    rel = qpos[:, None] - kpos[None, :]
    mask = (rel >= 0) & (rel < WINDOW) & (kpos[None, :] >= 0)
    o = sink_attend(qg, kk, vv, mask, sinks)
    return o.reshape(q.shape[0], T, Q_DIM), kk[:, -WINDOW:], vv[:, -WINDOW:]


def causal_conv(xbc, conv_state, w, bias):
    L = xbc.shape[1]
    xp = jnp.concatenate([conv_state.astype(xbc.dtype), xbc], axis=1)
    out = sum(xp[:, t:t + L] * w[t] for t in range(CONV_WIDTH)) + bias
    return jax.nn.silu(out), xp[:, -(CONV_WIDTH - 1):]


def ssd_scan(x, dt, a, b_in, c_in, d_skip, state0):
    f32 = jnp.float32
    in_dtype, st_dtype = x.dtype, state0.dtype
    x, dt, b_in, c_in = x.astype(f32), dt.astype(f32), b_in.astype(f32), c_in.astype(f32)
    bsz, L = x.shape[:2]
    Q = min(SSD_CHUNK, L)
    nc = -(-L // Q)
    pad = nc * Q - L
    if pad:
        padf = lambda t: jnp.pad(t, [(0, 0), (0, pad)] + [(0, 0)] * (t.ndim - 2))
        x, dt, b_in, c_in = padf(x), padf(dt), padf(b_in), padf(c_in)
    xc = x.reshape(bsz, nc, Q, SSM_GROUPS, SSM_HPG, SSM_HEAD_DIM)
    dtc = dt.reshape(bsz, nc, Q, SSM_GROUPS, SSM_HPG)
    bc = b_in.reshape(bsz, nc, Q, SSM_GROUPS, SSM_STATE)
    cc = c_in.reshape(bsz, nc, Q, SSM_GROUPS, SSM_STATE)
    cs = jnp.cumsum(dtc * a.astype(f32).reshape(SSM_GROUPS, SSM_HPG), axis=2)
    xdt = xc * dtc[..., None]
    cs_t = jnp.moveaxis(cs, 2, -1)
    causal = jnp.tril(jnp.ones((Q, Q), dtype=bool))
    decay = jnp.exp(jnp.where(causal, cs_t[..., :, None] - cs_t[..., None, :], -jnp.inf))
    cb = jnp.einsum('bcign,bcjgn->bcgij', cc, bc)
    y_diag = jnp.einsum('bcgij,bcgrij,bcjgrp->bcigrp', cb, decay, xdt)
    decay_end = jnp.exp(cs[:, :, -1:] - cs)
    chunk_states = jnp.einsum('bcjgn,bcjgr,bcjgrp->bcgrpn', bc, decay_end, xdt)
    chunk_decay = jnp.exp(cs[:, :, -1])

    def step(carry, inp):
        st, dec = inp
        return carry * dec[..., None, None] + st, carry

    s0 = state0.astype(f32).reshape(bsz, SSM_GROUPS, SSM_HPG, SSM_HEAD_DIM, SSM_STATE)
    final, prev = lax.scan(step, s0, (jnp.moveaxis(chunk_states, 1, 0), jnp.moveaxis(chunk_decay, 1, 0)))
    prev = jnp.moveaxis(prev, 0, 1)
    y_off = jnp.einsum('bcign,bcgrpn,bcigr->bcigrp', cc, prev, jnp.exp(cs))
    y = y_diag + y_off + xc * d_skip.astype(f32).reshape(SSM_GROUPS, SSM_HPG)[..., None]
    y = y.reshape(bsz, nc * Q, SSM_INNER)[:, :L]
    return y.astype(in_dtype), final.reshape(bsz, SSM_HEADS, SSM_HEAD_DIM, SSM_STATE).astype(st_dtype)


def gated_group_rmsnorm(y, z, g):
    h = (y * jax.nn.silu(z)).astype(jnp.float32)
    hg = h.reshape(h.shape[:-1] + (SSM_GROUPS, SSM_INNER // SSM_GROUPS))
    hg = hg * lax.rsqrt(jnp.mean(hg * hg, axis=-1, keepdims=True) + RMS_EPS)
    return hg.reshape(h.shape).astype(y.dtype) * g


def trunk_layer(h, p, pos, ck, cv, ssm0, conv0, prompt,
                w_in, conv_w, conv_b, dt_bias, a_log, d_skip, ssm_norm_g, attn_sinks, w_out,
                g_mix, g_ffn, w_ffn_gate, w_ffn_up, w_ffn_down, g_ple, w_ple, w_ple_gate):
    b, L = h.shape[:2]
    u = rmsnorm(h, g_mix)
    proj = u @ w_in
    offs = np.cumsum([Q_DIM, KV_DIM, KV_DIM, SSM_INNER, CONV_DIM]).tolist()
    q, k, v, z, xbc, dt_raw = jnp.split(proj, offs, axis=-1)
    q = partial_rope(q.reshape(b, L, N_HEADS, HEAD_DIM), pos)
    k = partial_rope(k.reshape(b, L, N_KV_HEADS, HEAD_DIM), pos)
    v = v.reshape(b, L, N_KV_HEADS, HEAD_DIM)
    if prompt:
        attn, new_k, new_v = window_attention_prompt(q, k, v, attn_sinks)
    else:
        attn, new_k, new_v = window_attention_sample(q, k, v, ck, cv, attn_sinks)
    xbc, new_conv = causal_conv(xbc, conv0, conv_w, conv_b)
    xs, bs, cs = jnp.split(xbc, [SSM_INNER, SSM_INNER + SSM_GROUPS * SSM_STATE], axis=-1)
    dt = jax.nn.softplus(dt_raw + dt_bias)
    a = -jnp.exp(a_log)
    y, new_ssm = ssd_scan(xs.reshape(b, L, SSM_HEADS, SSM_HEAD_DIM), dt, a,
                          bs.reshape(b, L, SSM_GROUPS, SSM_STATE), cs.reshape(b, L, SSM_GROUPS, SSM_STATE),
                          d_skip, ssm0)
    y = gated_group_rmsnorm(y, z, ssm_norm_g)
    h = h + jnp.concatenate([attn, y], axis=-1) @ w_out
    f = rmsnorm(h, g_ffn)
    h = h + (jax.nn.silu(f @ w_ffn_gate) * (f @ w_ffn_up)) @ w_ffn_down
    h = h + (p @ w_ple) * jax.nn.sigmoid(rmsnorm(h, g_ple) @ w_ple_gate)
    return h, new_k, new_v, new_ssm, new_conv


def setup_inputs(seed: int = 0) -> dict:
    key = jax.random.key(seed)
    ks = jax.random.split(key, 32)
    nrm = lambda i, shape, s: jax.random.normal(ks[i], shape, jnp.float32) * s
    dt0 = jnp.exp(jax.random.uniform(ks[13], (DEPTH, SSM_HEADS), jnp.float32, math.log(1e-3), math.log(1e-1)))
    return {
        "x_prompt": nrm(0, (BATCH, SEQ, D_MODEL), 1.0),
        "x_sample": nrm(1, (DEC_BATCH, DEC_SEQ, D_MODEL), 1.0),
        "cache_k": nrm(2, (DEPTH, DEC_BATCH, WINDOW, N_KV_HEADS, HEAD_DIM), 1.0),
        "cache_v": nrm(3, (DEPTH, DEC_BATCH, WINDOW, N_KV_HEADS, HEAD_DIM), 1.0),
        "state_ssm": nrm(4, (DEPTH, DEC_BATCH, SSM_HEADS, SSM_HEAD_DIM, SSM_STATE), 0.5),
        "state_conv": nrm(5, (DEPTH, DEC_BATCH, CONV_WIDTH - 1, CONV_DIM), 1.0),
        "p_prompt": nrm(6, (DEPTH, BATCH, SEQ, PLE_DIM), 1.0),
        "p_sample": nrm(7, (DEPTH, DEC_BATCH, DEC_SEQ, PLE_DIM), 1.0),
        "w_in": nrm(8, (DEPTH, D_MODEL, IN_DIM), D_MODEL ** -0.5),
        "conv_w": nrm(9, (DEPTH, CONV_WIDTH, CONV_DIM), CONV_WIDTH ** -0.5),
        "conv_b": nrm(10, (DEPTH, CONV_DIM), 0.01),
        "dt_bias": dt0 + jnp.log(-jnp.expm1(-dt0)),
        "a_log": jnp.log(jax.random.uniform(ks[11], (DEPTH, SSM_HEADS), jnp.float32, 1.0, 16.0)),
        "d_skip": 1.0 + nrm(12, (DEPTH, SSM_HEADS), 0.1),
        "ssm_norm_g": 1.0 + nrm(14, (DEPTH, SSM_INNER), 0.05),
        "attn_sinks": nrm(15, (DEPTH, N_HEADS), 0.5),
        "w_out": nrm(16, (DEPTH, MIX_WIDTH, D_MODEL), MIX_WIDTH ** -0.5),
        "g_mix": 1.0 + nrm(17, (DEPTH, D_MODEL), 0.05),
        "g_ffn": 1.0 + nrm(18, (DEPTH, D_MODEL), 0.05),
        "w_ffn_gate": nrm(19, (DEPTH, D_MODEL, FFN_HIDDEN), D_MODEL ** -0.5),
        "w_ffn_up": nrm(20, (DEPTH, D_MODEL, FFN_HIDDEN), D_MODEL ** -0.5),
        "w_ffn_down": nrm(21, (DEPTH, FFN_HIDDEN, D_MODEL), FFN_HIDDEN ** -0.5),
        "g_ple": 1.0 + nrm(22, (DEPTH, D_MODEL), 0.05),
        "w_ple": nrm(23, (DEPTH, PLE_DIM, D_MODEL), PLE_DIM ** -0.5),
        "w_ple_gate": nrm(24, (DEPTH, D_MODEL, D_MODEL), D_MODEL ** -0.5),
        "g_final": 1.0 + nrm(25, (D_MODEL,), 0.05),
    }


def reference(x_prompt, x_sample, cache_k, cache_v, state_ssm, state_conv, p_prompt, p_sample,
              w_in, conv_w, conv_b, dt_bias, a_log, d_skip, ssm_norm_g, attn_sinks, w_out,
              g_mix, g_ffn, w_ffn_gate, w_ffn_up, w_ffn_down, g_ple, w_ple, w_ple_gate, g_final):
    pos_prompt = jnp.arange(SEQ)
    pos_sample = PAST_LEN + jnp.arange(DEC_SEQ)
    hp, hs = x_prompt, x_sample
    kp, vp, sp, cp = [], [], [], []
    ksm, vsm, ssm_s, csm = [], [], [], []
    for i in range(DEPTH):
        params = (w_in[i], conv_w[i], conv_b[i], dt_bias[i], a_log[i], d_skip[i], ssm_norm_g[i],
                  attn_sinks[i], w_out[i], g_mix[i], g_ffn[i], w_ffn_gate[i], w_ffn_up[i],
                  w_ffn_down[i], g_ple[i], w_ple[i], w_ple_gate[i])
        zero_ssm = jnp.zeros((BATCH, SSM_HEADS, SSM_HEAD_DIM, SSM_STATE), hp.dtype)
        zero_conv = jnp.zeros((BATCH, CONV_WIDTH - 1, CONV_DIM), hp.dtype)
        hp, k1, v1, s1, c1 = trunk_layer(hp, p_prompt[i], pos_prompt, None, None, zero_ssm, zero_conv,
                                         True, *params)
        hs, k2, v2, s2, c2 = trunk_layer(hs, p_sample[i], pos_sample, cache_k[i], cache_v[i],
                                         state_ssm[i], state_conv[i], False, *params)
        kp.append(k1); vp.append(v1); sp.append(s1); cp.append(c1)
        ksm.append(k2); vsm.append(v2); ssm_s.append(s2); csm.append(c2)
    y_prompt = rmsnorm(hp, g_final)
    y_sample = rmsnorm(hs, g_final)
    return (y_prompt, y_sample,
            jnp.stack(kp), jnp.stack(vp), jnp.stack(sp), jnp.stack(cp),
            jnp.stack(ksm), jnp.stack(vsm), jnp.stack(ssm_s), jnp.stack(csm))
```

```cpp
#include <hip/hip_runtime.h>
#include <hip/hip_cooperative_groups.h>
#include <cstdio>
#include <cstdint>
namespace cg = cooperative_groups;
namespace pg8 {
#define PG8_LAS __attribute__((address_space(3)))
typedef unsigned short bf16_t;
typedef short bf16x8 __attribute__((ext_vector_type(8)));
typedef float f32x4 __attribute__((ext_vector_type(4)));
typedef unsigned u32x4 __attribute__((ext_vector_type(4)));
constexpr int BM = 256, BK = 64, HALF = 128, HTB = HALF * BK * 2  , STAGE_BYTES = 8 * HTB, NXCD = 8, WGM = 4;

__host__ __device__ __forceinline__ int lds_byte(int r, int c) { const int st = (r >> 4) * 2 + (c >> 5), rr = r & 15, cc = c & 31, ob = rr * 64 + cc * 2; return st * 1024 + (ob ^ (((ob >> 9) & 1) << 5)); }
__host__ __device__ __forceinline__ void stage_rc(int b, int& R, int& C) { const int st = b / 1024, sb = b % 1024, swz = sb ^ (((sb >> 9) & 1) << 5); R = (st >> 1) * 16 + swz / 64; C = (st & 1) * 32 + (swz % 64) / 2; }
__host__ __device__ __forceinline__ int perm32(int rho) { const int n = rho >> 4, i = rho & 15; return 8 * (i >> 2) + 4 * n + (i & 3); }

struct Unit { int pm, pn; };
struct Gemm { const bf16_t* A; const bf16_t* Bt; int M, N, K; };

struct StaticOrder {
    int nM, nN, nwg, G, c, wgm;
    __host__ __device__ void init(int M, int N, int G_, int c_, int wgm_ = WGM) { nM = M / BM; nN = N / BM; nwg = nM * nN; G = G_; c = c_; wgm = wgm_; }
    __host__ __device__ bool next(int i, Unit& u) const {
        const long L = (long)i * G + c; if (L >= nwg) return false;
        int wgid = (int)L; { const int q = nwg / NXCD, r = nwg % NXCD, xcd = wgid % NXCD, off = wgid / NXCD; wgid = (xcd < r ? xcd * (q + 1) : r * (q + 1) + (xcd - r) * q) + off; }
        const int nig = wgm * nN, gid = wgid / nig, fm = gid * wgm, gsz = (nM - fm) < wgm ? (nM - fm) : wgm;
        u.pm = fm + ((wgid % nig) % gsz); u.pn = (wgid % nig) / gsz; return true;
    }
    __device__ __forceinline__ void a_ready(const Unit&) const {}
    __device__ __forceinline__ void done(const Unit&) const {}
};

__device__ __forceinline__ unsigned cvt_pk_bf16(float lo, float hi) { unsigned r; asm volatile("v_cvt_pk_bf16_f32 %0, %1, %2" : "=v"(r) : "v"(lo), "v"(hi)); return r; }
template <class Epi, class Sched, bool ALIGN_EPI = false, bool SP2 = false>
__device__ __forceinline__ void gemm_phase(PG8_LAS unsigned char* lds, const Gemm g, const Sched& S, const Epi& E) {
    int tid0_ = threadIdx.x; asm volatile("" : "+v"(tid0_)); const int tid = tid0_, wid = __builtin_amdgcn_readfirstlane(tid >> 6), lane = tid & 63, wr = wid >> 2, wc = wid & 3, fr = lane & 15, fq = lane >> 4;
    const int K = g.K, nt = K / BK;
    unsigned voffA[2], voffB[2];
#pragma unroll
    for (int i = 0; i < 2; ++i) { int R, C; stage_rc(tid * 16 + i * 8192, R, C); const int Rb = Epi::PERM ? ((R & ~31) + perm32(R & 31)) : R;
        voffA[i] = (unsigned)(R * K + C) * 2u; voffB[i] = (unsigned)(Rb * K + C) * 2u; }
    const size_t kstep = (size_t)(BK * 2);
    const size_t hstep = (size_t)HALF * K * 2;
    const size_t tstep = 2 * hstep;
    const unsigned ldsw = (unsigned)wid * 1024u;
    const int aoff = lds_byte(wr * 64 + fr, fq * 8), boff = lds_byte(wc * 32 + fr, fq * 8);
#define PG8_SA(b, h) (((b) * 2 + (h)) * HTB)
#define PG8_SB(b, h) ((4 + (b) * 2 + (h)) * HTB)
#define PG8_STAGE(bufoff, gbase, voff) do { _Pragma("unroll") for (int _i = 0; _i < 2; ++_i) \
        __builtin_amdgcn_global_load_lds((const unsigned*)((const char*)(gbase) + (voff)[_i]), (PG8_LAS unsigned*)(lds + (bufoff) + ldsw + _i * 8192), 16, 0, 0); } while (0)
#define PG8_LDA(dst, b, h) do { _Pragma("unroll") for (int m = 0; m < 4; ++m) _Pragma("unroll") for (int k = 0; k < 2; ++k) dst[m][k] = *(const PG8_LAS bf16x8*)(lds + PG8_SA(b, h) + aoff + m * 2048 + k * 1024); } while (0)
#define PG8_LDB(dst, b, h) do { _Pragma("unroll") for (int n = 0; n < 2; ++n) _Pragma("unroll") for (int k = 0; k < 2; ++k) dst[n][k] = *(const PG8_LAS bf16x8*)(lds + PG8_SB(b, h) + boff + n * 2048 + k * 1024); } while (0)
#define PG8_MMA(ai, bj, At, Bt) do { __builtin_amdgcn_s_setprio(1); _Pragma("unroll") for (int m = 0; m < 4; ++m) _Pragma("unroll") for (int n = 0; n < 2; ++n) _Pragma("unroll") for (int k = 0; k < 2; ++k) \
        acc[ai][bj][m][n] = __builtin_amdgcn_mfma_f32_16x16x32_bf16(Bt[n][k], At[m][k], acc[ai][bj][m][n], 0, 0, 0); __builtin_amdgcn_s_setprio(0); } while (0)
#define PG8_WAIT_V(n) asm volatile("s_waitcnt vmcnt(" #n ")" ::: "memory")
#define PG8_WAIT_L(n) asm volatile("s_waitcnt lgkmcnt(" #n ")" ::: "memory")
#define PG8_BAR __builtin_amdgcn_s_barrier()
#define PG8_SCHED __builtin_amdgcn_sched_barrier(0)
    Unit cur, nxt; int ui = 0;
    if (!S.next(0, cur)) return;
    f32x4 acc[2][2][4][2];
#pragma unroll
    for (int a = 0; a < 2; ++a)
#pragma unroll
        for (int b = 0; b < 2; ++b)
#pragma unroll
            for (int m = 0; m < 4; ++m)
#pragma unroll
                for (int n = 0; n < 2; ++n) acc[a][b][m][n] = (f32x4){0.f, 0.f, 0.f, 0.f};
    bf16x8 At[4][2], B0[2][2], B1[2][2];
    const char* cA = (const char*)g.A + (size_t)cur.pm * tstep; const char* cB = (const char*)g.Bt + (size_t)cur.pn * tstep;
    S.a_ready(cur);
    if constexpr (SP2) {
        PG8_STAGE(PG8_SB(0, 0), cB, voffB); PG8_STAGE(PG8_SB(0, 1), cB + hstep, voffB); PG8_STAGE(PG8_SA(0, 0), cA, voffA); PG8_STAGE(PG8_SA(0, 1), cA + hstep, voffA);
        if (wr == 1) PG8_BAR;
        PG8_WAIT_V(2); PG8_BAR;
        PG8_STAGE(PG8_SB(1, 0), cB + kstep, voffB); PG8_STAGE(PG8_SA(1, 0), cA + kstep, voffA); PG8_STAGE(PG8_SB(1, 1), cB + hstep + kstep, voffB);
        PG8_WAIT_V(6); PG8_BAR;
    } else {
        PG8_STAGE(PG8_SB(0, 0), cB, voffB); PG8_STAGE(PG8_SA(0, 0), cA, voffA); PG8_STAGE(PG8_SB(0, 1), cB + hstep, voffB); PG8_STAGE(PG8_SA(0, 1), cA + hstep, voffA);
        if (wr == 1) PG8_BAR;
        PG8_WAIT_V(4); PG8_BAR;
        PG8_STAGE(PG8_SB(1, 0), cB + kstep, voffB); PG8_STAGE(PG8_SA(1, 0), cA + kstep, voffA); PG8_STAGE(PG8_SB(1, 1), cB + hstep + kstep, voffB);
        PG8_WAIT_V(6); PG8_BAR;
    }
    for (;;) {
        const bool has_next = S.next(ui + 1, nxt);
        const char* nA = has_next ? (const char*)g.A + (size_t)nxt.pm * tstep : cA; const char* nB = has_next ? (const char*)g.Bt + (size_t)nxt.pn * tstep : cB;
        for (int t = 0; t < nt; t += 2) {
            const bool last = (t == nt - 2);
            const char* a1 = cA + (size_t)(t + 1) * kstep;
            const char* a2 = last ? nA : cA + (size_t)(t + 2) * kstep; const char* b2 = last ? nB : cB + (size_t)(t + 2) * kstep;
            const char* a3 = a2 + kstep; const char* b3 = b2 + kstep;
            if (last && has_next) S.a_ready(nxt);
            if constexpr (SP2) {
            PG8_LDB(B0, 0, 0); PG8_LDB(B1, 0, 1); PG8_SCHED; PG8_LDA(At, 0, 0); PG8_STAGE(PG8_SA(1, 1), a1 + hstep, voffA);
            PG8_WAIT_V(8); PG8_WAIT_L(0); PG8_BAR; PG8_MMA(0, 0, At, B0); PG8_MMA(0, 1, At, B1); PG8_BAR; PG8_SCHED;
            PG8_LDA(At, 0, 1); PG8_STAGE(PG8_SB(0, 0), b2, voffB); PG8_STAGE(PG8_SB(0, 1), b2 + hstep, voffB); PG8_STAGE(PG8_SA(0, 0), a2, voffA);
            PG8_WAIT_V(8); PG8_WAIT_L(0); PG8_BAR; PG8_MMA(1, 0, At, B0); PG8_MMA(1, 1, At, B1); PG8_BAR; PG8_SCHED;
            PG8_LDB(B0, 1, 0); PG8_LDB(B1, 1, 1); PG8_SCHED; PG8_LDA(At, 1, 0); PG8_STAGE(PG8_SA(0, 1), a2 + hstep, voffA);
            PG8_WAIT_V(8); PG8_WAIT_L(0); PG8_BAR; PG8_MMA(0, 0, At, B0); PG8_MMA(0, 1, At, B1); PG8_BAR; PG8_SCHED;
            PG8_LDA(At, 1, 1); PG8_STAGE(PG8_SB(1, 0), b3, voffB); PG8_STAGE(PG8_SB(1, 1), b3 + hstep, voffB); PG8_STAGE(PG8_SA(1, 0), a3, voffA);
            PG8_WAIT_V(8); PG8_WAIT_L(0); PG8_BAR; PG8_MMA(1, 0, At, B0); PG8_MMA(1, 1, At, B1); PG8_BAR; PG8_SCHED;
            } else {
            PG8_LDB(B0, 0, 0); PG8_SCHED; PG8_LDA(At, 0, 0); PG8_STAGE(PG8_SA(1, 1), a1 + hstep, voffA);
            PG8_WAIT_L(8); PG8_BAR; PG8_WAIT_L(0); PG8_MMA(0, 0, At, B0); PG8_BAR; PG8_SCHED;
            PG8_LDB(B1, 0, 1); PG8_STAGE(PG8_SB(0, 0), b2, voffB);
            PG8_BAR; PG8_WAIT_L(0); PG8_MMA(0, 1, At, B1); PG8_BAR;
            PG8_LDA(At, 0, 1); PG8_STAGE(PG8_SA(0, 0), a2, voffA);
            PG8_BAR; PG8_WAIT_L(0); PG8_MMA(1, 0, At, B0); PG8_BAR; PG8_SCHED;
            PG8_STAGE(PG8_SB(0, 1), b2 + hstep, voffB);
            PG8_WAIT_V(6); PG8_BAR; PG8_MMA(1, 1, At, B1); PG8_BAR;
            PG8_LDB(B0, 1, 0); PG8_SCHED; PG8_LDA(At, 1, 0); PG8_STAGE(PG8_SA(0, 1), a2 + hstep, voffA);
            PG8_WAIT_L(8); PG8_BAR; PG8_WAIT_L(0); PG8_MMA(0, 0, At, B0); PG8_BAR; PG8_SCHED;
            PG8_LDB(B1, 1, 1); PG8_STAGE(PG8_SB(1, 0), b3, voffB);
            PG8_BAR; PG8_WAIT_L(0); PG8_MMA(0, 1, At, B1); PG8_BAR;
            PG8_LDA(At, 1, 1); PG8_STAGE(PG8_SA(1, 0), a3, voffA);
            PG8_BAR; PG8_WAIT_L(0); PG8_MMA(1, 0, At, B0); PG8_BAR; PG8_SCHED;
            PG8_STAGE(PG8_SB(1, 1), b3 + hstep, voffB);
            PG8_WAIT_V(6); PG8_BAR; PG8_MMA(1, 1, At, B1); PG8_BAR;
            }
        }
        if constexpr (ALIGN_EPI) { if (wr == 0) PG8_BAR; }
        if constexpr (!Epi::AFTER_DRAIN) { E(acc, cur, wr, wc, fr, fq); S.done(cur); }
        if (!has_next) break;
#pragma unroll
        for (int a = 0; a < 2; ++a)
#pragma unroll
            for (int b = 0; b < 2; ++b)
#pragma unroll
                for (int m = 0; m < 4; ++m)
#pragma unroll
                    for (int n = 0; n < 2; ++n) acc[a][b][m][n] = (f32x4){0.f, 0.f, 0.f, 0.f};
        cur = nxt; cA = nA; cB = nB; ++ui;
        if constexpr (ALIGN_EPI) { if (wr == 1) PG8_BAR; }
    }
    PG8_WAIT_V(0);
    if constexpr (!ALIGN_EPI) { if (wr == 0) PG8_BAR; }
    PG8_BAR;
    if constexpr (Epi::AFTER_DRAIN) { E.fused(acc, cur, wr, wc, fr, fq, lds, wid, lane); S.done(cur); }
#undef PG8_SA
#undef PG8_SB
#undef PG8_STAGE
#undef PG8_LDA
#undef PG8_LDB
#undef PG8_MMA
#undef PG8_WAIT_V
#undef PG8_WAIT_L
#undef PG8_BAR
#undef PG8_SCHED
}
}
constexpr int DM = 2048, SEQ = 8192, MREAL = 16512, MP = 16640;
constexpr int LDP = 4864, FF = 5632, INDIM = 4624;
constexpr int C_Q = 0, C_K = 1024, C_V = 1280, C_Z = 1536, C_X = 2560, C_DT = 4608;
constexpr float EPS = 1e-6f, LOG2E = 1.4426950408889634f;

namespace pg8 {
__device__ __forceinline__ float softplus_f(float x) { const float e = __builtin_amdgcn_exp2f(-fabsf(x) * LOG2E);
    const float l = (e < 0.03f) ? e * (1.0f - e * (0.5f - e * 0.33333333f)) : __builtin_amdgcn_logf(1.0f + e) * 0.6931471805599453f; return fmaxf(x, 0.f) + l; }
__device__ __forceinline__ float sigmoid_f(float x) { return __builtin_amdgcn_rcpf(1.0f + __builtin_amdgcn_exp2f(-x * LOG2E)); }
__device__ __forceinline__ u32x4 pack8(f32x4 v0, f32x4 v1) { u32x4 w; w.x = cvt_pk_bf16(v0[0], v0[1]); w.y = cvt_pk_bf16(v0[2], v0[3]); w.z = cvt_pk_bf16(v1[0], v1[1]); w.w = cvt_pk_bf16(v1[2], v1[3]); return w; }

struct EpiProj {
    static constexpr bool PERM = true, AFTER_DRAIN = false;
    bf16_t* O; float* dt; const float* tab; const float* dt_bias; const float* r0;
    __device__ __forceinline__ void operator()(const f32x4 (&acc)[2][2][4][2], const Unit& u, int wr, int wc, int fr, int fq) const {
        const int row0 = u.pm * BM + wr * 64 + fr;
        const bool rope = (u.pn < 5) && ((wc & 1) == 0);
        const bool dtt = (u.pn == 18) && (wc == 0);
        float rr0[2][4];
#pragma unroll
        for (int ai = 0; ai < 2; ++ai)
#pragma unroll
            for (int m = 0; m < 4; ++m) rr0[ai][m] = r0[row0 + ai * HALF + m * 16];
#pragma unroll
        for (int ai = 0; ai < 2; ++ai) {
#pragma unroll
            for (int m = 0; m < 4; ++m) {
                const int row = row0 + ai * HALF + m * 16;
                bf16_t* rowp = O + (size_t)row * LDP + u.pn * BM + wc * 32 + 8 * fq;
                const float rs0 = rr0[ai][m];
                f32x4 cs0 = {1.f, 1.f, 1.f, 1.f}, cs1 = cs0, sn0 = {0.f, 0.f, 0.f, 0.f}, sn1 = sn0;
                if (rope) { const int pos = row < 16384 ? (row & 8191) : 8192; const float* t = tab + (size_t)pos * 16;
                    cs0 = *(const f32x4*)t; cs1 = *(const f32x4*)(t + 4); sn0 = *(const f32x4*)(t + 8); sn1 = *(const f32x4*)(t + 12); }
#pragma unroll
                for (int bj = 0; bj < 2; ++bj) {
                    f32x4 v0 = acc[ai][bj][m][0] * rs0, v1 = acc[ai][bj][m][1] * rs0;
                    if (rope) {
                        f32x4 o0, o1;
#pragma unroll
                        for (int j = 0; j < 4; ++j) { o0[j] = __shfl_xor(v0[j], 16); o1[j] = __shfl_xor(v1[j], 16); }
                        if (fq == 0) { v0 = v0 * cs0 - o0 * sn0; v1 = v1 * cs1 - o1 * sn1; }
                        else if (fq == 1) { v0 = v0 * cs0 + o0 * sn0; v1 = v1 * cs1 + o1 * sn1; }
                    }
                    *(u32x4*)(rowp + bj * HALF) = pack8(v0, v1);
                    if (dtt && bj == 0 && fq < 2) {
                        float* dp = dt + (size_t)row * 16 + 8 * fq; const float* bb = dt_bias + 8 * fq;
                        f32x4 a, b;
#pragma unroll
                        for (int j = 0; j < 4; ++j) { a[j] = softplus_f(v0[j] + bb[j]); b[j] = softplus_f(v1[j] + bb[4 + j]); }
                        *(f32x4*)dp = a; *(f32x4*)(dp + 4) = b;
                    }
                }
                asm volatile("" ::: "memory");
            }
        }
    }
};
struct EpiPlain {
    static constexpr bool PERM = true, AFTER_DRAIN = false;
    bf16_t* O;
    __device__ __forceinline__ void operator()(const f32x4 (&acc)[2][2][4][2], const Unit& u, int wr, int wc, int fr, int fq) const {
        const int row0 = u.pm * BM + wr * 64 + fr;
#pragma unroll
        for (int ai = 0; ai < 2; ++ai)
#pragma unroll
            for (int m = 0; m < 4; ++m) {
                bf16_t* rowp = O + (size_t)(row0 + ai * HALF + m * 16) * DM + u.pn * BM + wc * 32 + 8 * fq;
#pragma unroll
                for (int bj = 0; bj < 2; ++bj) *(u32x4*)(rowp + bj * HALF) = pack8(acc[ai][bj][m][0], acc[ai][bj][m][1]);
            }
    }
};
template <bool XBASE> struct EpiRes {
    static constexpr bool PERM = true, AFTER_DRAIN = false;
    const float* X; bf16_t* HB; float* ss;
    __device__ __forceinline__ void operator()(const f32x4 (&acc)[2][2][4][2], const Unit& u, int wr, int wc, int fr, int fq) const {
        const int row0 = u.pm * BM + wr * 64 + fr;
        const size_t off0 = (size_t)row0 * DM + u.pn * BM + wc * 32 + 8 * fq;
#pragma unroll
        for (int ai = 0; ai < 2; ++ai) {
            u32x4 hb[4][2];
            if (!XBASE) {
#pragma unroll
                for (int m = 0; m < 4; ++m)
#pragma unroll
                    for (int bj = 0; bj < 2; ++bj) hb[m][bj] = *(const u32x4*)(HB + off0 + (size_t)(ai * HALF + m * 16) * DM + bj * HALF);
            }
#pragma unroll
            for (int m = 0; m < 4; ++m) {
                const int row = row0 + ai * HALF + m * 16;
                const size_t off = off0 + (size_t)(ai * HALF + m * 16) * DM;
                float sq = 0.f;
#pragma unroll
                for (int bj = 0; bj < 2; ++bj) {
                    f32x4 b0, b1;
                    if (XBASE) { b0 = *(const f32x4*)(X + off + bj * HALF); b1 = *(const f32x4*)(X + off + bj * HALF + 4); }
                    else { const u32x4 h = hb[m][bj];
                        b0 = (f32x4){__uint_as_float(h.x << 16), __uint_as_float(h.x & 0xffff0000u), __uint_as_float(h.y << 16), __uint_as_float(h.y & 0xffff0000u)};
                        b1 = (f32x4){__uint_as_float(h.z << 16), __uint_as_float(h.z & 0xffff0000u), __uint_as_float(h.w << 16), __uint_as_float(h.w & 0xffff0000u)}; }
                    const f32x4 v0 = b0 + acc[ai][bj][m][0], v1 = b1 + acc[ai][bj][m][1];
                    *(u32x4*)(HB + off + bj * HALF) = pack8(v0, v1);
                    sq += (v0[0] * v0[0] + v0[1] * v0[1]) + (v0[2] * v0[2] + v0[3] * v0[3]) + (v1[0] * v1[0] + v1[1] * v1[1]) + (v1[2] * v1[2] + v1[3] * v1[3]);
                }
                sq += __shfl_xor(sq, 16); sq += __shfl_xor(sq, 32);
                if (fq == 0) atomicAdd(ss + row, sq);
            }
            asm volatile("" ::: "memory");
        }
    }
};
struct EpiGateUp {
    static constexpr bool PERM = true, AFTER_DRAIN = false;
    bf16_t* O; const float* ss;
    __device__ __forceinline__ void operator()(const f32x4 (&acc)[2][2][4][2], const Unit& u, int wr, int wc, int fr, int fq) const {
        const int row0 = u.pm * BM + wr * 64 + fr;
        float rr[2][4];
#pragma unroll
        for (int ai = 0; ai < 2; ++ai)
#pragma unroll
            for (int m = 0; m < 4; ++m) rr[ai][m] = ss[row0 + ai * HALF + m * 16];
#pragma unroll
        for (int ai = 0; ai < 2; ++ai)
#pragma unroll
            for (int m = 0; m < 4; ++m) {
                const int row = row0 + ai * HALF + m * 16;
                const float r = 1.0f / sqrtf(rr[ai][m] * (1.0f / DM) + EPS);
                f32x4 h0, h1;
#pragma unroll
                for (int j = 0; j < 4; ++j) {
                    const float g0 = acc[ai][0][m][0][j] * r, g1 = acc[ai][0][m][1][j] * r;
                    h0[j] = g0 * sigmoid_f(g0) * (acc[ai][1][m][0][j] * r); h1[j] = g1 * sigmoid_f(g1) * (acc[ai][1][m][1][j] * r);
                }
                *(u32x4*)(O + (size_t)row * FF + u.pn * HALF + wc * 32 + 8 * fq) = pack8(h0, h1);
            }
    }
};
struct EpiPle {
    static constexpr bool PERM = true, AFTER_DRAIN = false;
    const bf16_t* HB; bf16_t* H3; const bf16_t* PE; const float* ss;
    __device__ __forceinline__ void operator()(const f32x4 (&acc)[2][2][4][2], const Unit& u, int wr, int wc, int fr, int fq) const {
        const int row0 = u.pm * BM + wr * 64 + fr;
        const size_t off0 = (size_t)row0 * DM + u.pn * BM + wc * 32 + 8 * fq;
        float rr[2][4];
#pragma unroll
        for (int ai = 0; ai < 2; ++ai)
#pragma unroll
            for (int m = 0; m < 4; ++m) rr[ai][m] = ss[row0 + ai * HALF + m * 16];
#pragma unroll
        for (int ai = 0; ai < 2; ++ai) {
            u32x4 hbv[4][2], pev[4][2];
#pragma unroll
            for (int m = 0; m < 4; ++m)
#pragma unroll
                for (int bj = 0; bj < 2; ++bj) { const size_t off = off0 + (size_t)(ai * HALF + m * 16) * DM + bj * HALF; hbv[m][bj] = *(const u32x4*)(HB + off); pev[m][bj] = *(const u32x4*)(PE + off); }
#pragma unroll
            for (int m = 0; m < 4; ++m) {
                const float r = 1.0f / sqrtf(rr[ai][m] * (1.0f / DM) + EPS);
#pragma unroll
                for (int bj = 0; bj < 2; ++bj) {
                    const size_t off = off0 + (size_t)(ai * HALF + m * 16) * DM + bj * HALF;
                    const u32x4 pe = pev[m][bj], hb = hbv[m][bj];
                    const f32x4 a0 = acc[ai][bj][m][0] * r, a1 = acc[ai][bj][m][1] * r;
                    f32x4 h0, h1;
                    h0[0] = __uint_as_float(hb.x << 16) + __uint_as_float(pe.x << 16) * sigmoid_f(a0[0]); h0[1] = __uint_as_float(hb.x & 0xffff0000u) + __uint_as_float(pe.x & 0xffff0000u) * sigmoid_f(a0[1]);
                    h0[2] = __uint_as_float(hb.y << 16) + __uint_as_float(pe.y << 16) * sigmoid_f(a0[2]); h0[3] = __uint_as_float(hb.y & 0xffff0000u) + __uint_as_float(pe.y & 0xffff0000u) * sigmoid_f(a0[3]);
                    h1[0] = __uint_as_float(hb.z << 16) + __uint_as_float(pe.z << 16) * sigmoid_f(a1[0]); h1[1] = __uint_as_float(hb.z & 0xffff0000u) + __uint_as_float(pe.z & 0xffff0000u) * sigmoid_f(a1[1]);
                    h1[2] = __uint_as_float(hb.w << 16) + __uint_as_float(pe.w << 16) * sigmoid_f(a1[2]); h1[3] = __uint_as_float(hb.w & 0xffff0000u) + __uint_as_float(pe.w & 0xffff0000u) * sigmoid_f(a1[3]);
                    *(u32x4*)(H3 + off) = pack8(h0, h1);
                }
            }
            asm volatile("" ::: "memory");
        }
    }
};
}
#define LAS __attribute__((address_space(3)))
#define XB_TMO      128
#define XB_XCNT(j)  (256  + 64 * (j))
#define XB_XSUB(j)  (1280 + 64 * (j))
#define XB_XGEN(j)  (2304 + 64 * (j))
#define XB_TOP      3328
#define XB_TOPGEN   3392
#define XCD_BAR_WORDS 3456
#define XB_SPIN_CAP (1u << 18)

__device__ __forceinline__ unsigned xb_ld(unsigned* p)              { return __hip_atomic_load(p, __ATOMIC_RELAXED, __HIP_MEMORY_SCOPE_AGENT); }
__device__ __forceinline__ unsigned xb_add(unsigned* p, unsigned v) { return __hip_atomic_fetch_add(p, v, __ATOMIC_RELAXED, __HIP_MEMORY_SCOPE_AGENT); }
__device__ __forceinline__ unsigned xb_xcc_id() { return (unsigned)__builtin_amdgcn_s_getreg((3 << 11) | 20) & 0xFu; }
#define XB_SPIN(cond, bar) do { unsigned _sp = 0; while (cond) { __builtin_amdgcn_s_sleep(1); \
    if ((++_sp & 255u) == 0u) { if (xb_ld(&(bar)[XB_TMO])) break; if (_sp > XB_SPIN_CAP) { atomicAdd(&(bar)[XB_TMO], 1u); break; } } } } while (0)

struct XcdBarrier {
    unsigned* bar; unsigned x;
    volatile LAS unsigned* st;
};

__device__ __forceinline__ XcdBarrier xcd_barrier_post(unsigned* bar, volatile LAS unsigned* st) {
    XcdBarrier b; b.bar = bar; b.x = xb_xcc_id(); b.st = st;
    if (threadIdx.x == 0) (void)xb_add(&bar[XB_XCNT(b.x)], 1u);
    return b;
}
__device__ __forceinline__ void xcd_barrier_complete(unsigned* bar, unsigned x, unsigned& nloc, unsigned& nx) {
    const unsigned G = gridDim.x * gridDim.y * gridDim.z;
    unsigned sum, cnt, mine, sp = 0u;
    for (;;) {
        sum = 0u; cnt = 0u; mine = 0u;
#pragma unroll
        for (unsigned j = 0; j < 16; ++j) { const unsigned c = xb_ld(&bar[XB_XCNT(j)]); sum += c; cnt += (c > 0u) ? 1u : 0u; mine = (j == x) ? c : mine; }
        if (sum == G) break;
        __builtin_amdgcn_s_sleep(1);
        if ((++sp & 255u) == 0u) { if (xb_ld(&bar[XB_TMO])) break; if (sp > XB_SPIN_CAP) { atomicAdd(&bar[XB_TMO], 1u); break; } }
    }
    nloc = mine > 0u ? mine : 1u; nx = cnt > 0u ? cnt : 1u;
}

__device__ __forceinline__ void xcd_barrier(const XcdBarrier& b) {
    asm volatile("s_waitcnt vmcnt(0)" ::: "memory");
    __syncthreads();
    if (threadIdx.x == 0) {
        unsigned* bar = b.bar;
        __builtin_amdgcn_s_waitcnt(0);
        unsigned nloc = b.st[0], nx = b.st[1];
        if (nloc == 0u) { xcd_barrier_complete(bar, b.x, nloc, nx); b.st[0] = nloc; b.st[1] = nx; }
        const unsigned old = xb_add(&bar[XB_XSUB(b.x)], 1u);
        const unsigned gen = old / nloc;
        if (old + 1u == (gen + 1u) * nloc) {
            __builtin_amdgcn_fence(__ATOMIC_RELEASE, "agent");
            asm volatile("s_waitcnt vmcnt(0)" ::: "memory");
            const unsigned og = xb_add(&bar[XB_TOP], 1u);
            const unsigned tg = og / nx;
            if (og + 1u == (tg + 1u) * nx) xb_add(&bar[XB_TOPGEN], 1u);
            else XB_SPIN(xb_ld(&bar[XB_TOPGEN]) == tg, bar);
            __builtin_amdgcn_fence(__ATOMIC_ACQUIRE, "agent");
            xb_add(&bar[XB_XGEN(b.x)], 1u);
            asm volatile("s_waitcnt vmcnt(0)" ::: "memory");
        } else {
            XB_SPIN(xb_ld(&bar[XB_XGEN(b.x)]) == gen, bar);
            __builtin_amdgcn_fence(__ATOMIC_ACQUIRE, "agent");
            asm volatile("s_waitcnt vmcnt(0)" ::: "memory");
        }
    }
    __syncthreads();
}
typedef unsigned short bf16;
typedef short bf16x8 __attribute__((ext_vector_type(8)));
typedef float f32x4 __attribute__((ext_vector_type(4)));
typedef float f32x2 __attribute__((ext_vector_type(2)));
typedef float f32x16 __attribute__((ext_vector_type(16)));
typedef unsigned u32x4 __attribute__((ext_vector_type(4)));
typedef unsigned u32x2 __attribute__((ext_vector_type(2)));

constexpr size_t MiB = 1u << 20;
constexpr size_t WS_WIN = 0 * MiB;
constexpr size_t WS_WO = 19 * MiB;
constexpr size_t WS_WGU = 27 * MiB;
constexpr size_t WS_WD = 71 * MiB;
constexpr size_t WS_WP = 93 * MiB;
constexpr size_t WS_WPG = 94 * MiB;
constexpr size_t WS_DT = 102 * MiB;
constexpr size_t WS_TAB = 104 * MiB;
constexpr size_t WS_SS1 = 105 * MiB;
constexpr size_t WS_SS2 = 105 * MiB + 128 * 1024;
constexpr size_t WS_R0 = 105 * MiB + 640 * 1024;
constexpr size_t WS_DEC = 105 * MiB + 256 * 1024;
constexpr size_t WS_BAR = 105 * MiB + 512 * 1024;
constexpr size_t WS_PB = 106 * MiB;
constexpr size_t WS_U = 115 * MiB;
constexpr size_t WS_MIX = 180 * MiB;
constexpr size_t WS_PROJ = 245 * MiB;
constexpr size_t WS_END = 424 * MiB;
constexpr size_t WS_H3 = 0;
constexpr size_t O_Y = 0, O_KP = 33816576, O_VP = 33882112, O_SSMP = 33947648, O_CONVP = 34209792, O_KS = 34222080, O_VS = 38416384, O_SSMS = 42610688, O_CONVS = 59387904;
constexpr size_t OS_STATES = 0;
constexpr size_t OS_PREV = 16777216;

struct Params { const float* in[26]; float* out; unsigned char* ws; };

typedef __bf16 bf16x2_t __attribute__((ext_vector_type(2)));
__device__ __forceinline__ unsigned pk2(float lo, float hi) { f32x2 v = {lo, hi}; bf16x2_t b = __builtin_convertvector(v, bf16x2_t); return __builtin_bit_cast(unsigned, b); }
__device__ __forceinline__ unsigned f2bf(float f) { return pk2(f, 0.f) & 0xffffu; }
__device__ __forceinline__ float bf2f(bf16 b) { return __uint_as_float(((unsigned)b) << 16); }
__device__ __forceinline__ float bflo(unsigned w) { return __uint_as_float(w << 16); }
__device__ __forceinline__ float bfhi(unsigned w) { return __uint_as_float(w & 0xffff0000u); }
__device__ __forceinline__ int crow(int r, int hi) { return (r & 3) + 8 * (r >> 2) + 4 * hi; }
__device__ __forceinline__ float wave_sum(float v) {
#pragma unroll
    for (int o = 1; o < 64; o <<= 1) v += __shfl_xor(v, o);
    return v;
}
__device__ __forceinline__ float wave_max(float v) {
#pragma unroll
    for (int o = 1; o < 64; o <<= 1) v = fmaxf(v, __shfl_xor(v, o));
    return v;
}
__device__ __forceinline__ float fexp(float x) { return __builtin_amdgcn_exp2f(x * LOG2E); }
__device__ __forceinline__ float silu_f(float x) { return x * __builtin_amdgcn_rcpf(1.0f + __builtin_amdgcn_exp2f(-x * LOG2E)); }
#define MFMA32(a, b, c) __builtin_amdgcn_mfma_f32_32x32x16_bf16((a), (b), (c), 0, 0, 0)
#define LDSW() asm volatile("s_waitcnt lgkmcnt(0)" ::: "memory")

struct Ctx { int tid, lane, wid; };
#define WSP(T, off) ((T*)(p.ws + (off)))
__device__ __forceinline__ Ctx mk_ctx() { int t = threadIdx.x; asm volatile("" : "+v"(t)); Ctx F; F.tid = t; F.lane = t & 63; F.wid = __builtin_amdgcn_readfirstlane(t >> 6); return F; }

__device__ __forceinline__ void p0_transpose_item(const float* W, int K, int N, bf16* WT, float* scr, int item, int lane, const float* gk, int mode, int nblk) {
    const int kb = item / nblk, nb = item % nblk, k0 = 64 * kb, n0 = 32 * nb;
    const int kr = lane >> 3, n4 = (lane & 7) * 4; const bool ok = (n0 + n4) < N;
#pragma unroll
    for (int i = 0; i < 8; ++i) { const int kk = kr + 8 * i; f32x4 v = {0.f, 0.f, 0.f, 0.f};
        if (ok) v = __builtin_nontemporal_load((const f32x4*)(W + (size_t)(k0 + kk) * N + n0 + n4));
        if (gk) v = v * gk[k0 + kk];
        float* d = scr + kk * 33 + n4; d[0] = v[0]; d[1] = v[1]; d[2] = v[2]; d[3] = v[3]; }
    LDSW();
    const int c = lane & 7;
#pragma unroll
    for (int j = 0; j < 4; ++j) { const int n = (lane >> 3) + 8 * j; const float* s = scr + (8 * c) * 33 + n;
        u32x4 o; o.x = pk2(s[0 * 33], s[1 * 33]); o.y = pk2(s[2 * 33], s[3 * 33]); o.z = pk2(s[4 * 33], s[5 * 33]); o.w = pk2(s[6 * 33], s[7 * 33]);
        const int nd = n0 + n; const int drow = (mode == 0) ? nd : ((nd >> 7) * 256 + (nd & 127) + (mode == 2 ? 128 : 0));
        *(u32x4*)(WT + (size_t)drow * K + k0 + 8 * c) = o; }
    LDSW();
}
__device__ __forceinline__ void p0_prologue(const Params& p, const Ctx& F, unsigned char* lds) {
    float* scr = (float*)(lds + F.wid * 16384);
    const int G = gridDim.x, gw = blockIdx.x * 8 + F.wid, NGW = G * 8, lane = F.lane;
    constexpr int I_IN = 32 * 152, I_O = 32 * 64, I_G = 32 * 176, I_D = 88 * 64, I_P = 4 * 64, I_PG = 32 * 64;
    constexpr int NITEMS = I_IN + I_O + 2 * I_G + I_D + I_P + I_PG;
    for (int it = gw; it < NITEMS; it += NGW) {
        int r = it;
        if (r < I_IN) { p0_transpose_item(p.in[8], 2048, INDIM, WSP(bf16, WS_WIN), scr, r, lane, p.in[17], 0, 152); continue; } r -= I_IN;
        if (r < I_O) { p0_transpose_item(p.in[16], 2048, 2048, WSP(bf16, WS_WO), scr, r, lane, nullptr, 0, 64); continue; } r -= I_O;
        if (r < I_G) { p0_transpose_item(p.in[19], 2048, FF, WSP(bf16, WS_WGU), scr, r, lane, p.in[18], 1, 176); continue; } r -= I_G;
        if (r < I_G) { p0_transpose_item(p.in[20], 2048, FF, WSP(bf16, WS_WGU), scr, r, lane, p.in[18], 2, 176); continue; } r -= I_G;
        if (r < I_D) { p0_transpose_item(p.in[21], FF, 2048, WSP(bf16, WS_WD), scr, r, lane, nullptr, 0, 64); continue; } r -= I_D;
        if (r < I_P) { p0_transpose_item(p.in[23], 256, 2048, WSP(bf16, WS_WP), scr, r, lane, nullptr, 0, 64); continue; } r -= I_P;
        p0_transpose_item(p.in[24], 2048, 2048, WSP(bf16, WS_WPG), scr, r, lane, p.in[22], 0, 64);
    }
    const float* gm = p.in[17];
    for (int m = gw; m < MP; m += NGW) {
        unsigned long long* o8 = (unsigned long long*)(WSP(bf16, WS_U) + (size_t)m * DM) + lane;
        unsigned long long* p8 = (unsigned long long*)(WSP(bf16, WS_PB) + (size_t)m * 256) + lane;
        if (m >= MREAL) {
#pragma unroll
            for (int j = 0; j < 8; ++j) o8[64 * j] = 0ull;
            p8[0] = 0ull; continue;
        }
        const float* xr = (m < 16384) ? p.in[0] + (size_t)m * DM : p.in[1] + (size_t)(m - 16384) * DM;
        const float* pr = (m < 16384) ? p.in[6] + (size_t)m * 256 : p.in[7] + (size_t)(m - 16384) * 256;
        f32x4 v[8]; float s = 0.f;
#pragma unroll
        for (int j = 0; j < 8; ++j) { v[j] = __builtin_nontemporal_load((const f32x4*)xr + lane + 64 * j); s += (v[j][0] * v[j][0] + v[j][1] * v[j][1]) + (v[j][2] * v[j][2] + v[j][3] * v[j][3]); }
        const float rstd = 1.0f / sqrtf(wave_sum(s) * (1.0f / DM) + EPS);
        if (lane == 0) WSP(float, WS_R0)[m] = rstd;
#pragma unroll
        for (int j = 0; j < 8; ++j) o8[64 * j] = (unsigned long long)pk2(v[j][0], v[j][1]) | ((unsigned long long)pk2(v[j][2], v[j][3]) << 32);
        const f32x4 pv = ((const f32x4*)pr)[lane];
        p8[0] = (unsigned long long)pk2(pv[0], pv[1]) | ((unsigned long long)pk2(pv[2], pv[3]) << 32);
    }
    const int gt = blockIdx.x * 512 + F.tid, NT = G * 512;
    for (int pi = gt; pi < 8193; pi += NT) {
        const double pos = (pi < 8192) ? (double)pi : 16384.0;
        const double INV[8] = {1.0, 0.19392274474868576, 0.03760603093086393, 0.007292664737217109, 0.001414213562373095, 0.0002742481756762073, 5.318295896944988e-05, 1.031338537721246e-05};
#pragma unroll
        for (int i = 0; i < 8; ++i) { double rev = pos * INV[i] * 0.15915494309189535; rev -= __builtin_rint(rev); const float rf = (float)rev;
            WSP(float, WS_TAB)[(size_t)pi * 16 + i] = __builtin_amdgcn_cosf(rf); WSP(float, WS_TAB)[(size_t)pi * 16 + 8 + i] = __builtin_amdgcn_sinf(rf); }
    }
    for (int i = gt; i < MP; i += NT) { WSP(float, WS_SS1)[i] = 0.f; WSP(float, WS_SS2)[i] = 0.f; }
}

__device__ __forceinline__ void conv8(const Params& p, const Ctx& F, long tok, int tpos, int ch, float (&out)[8]) {
    const float* cw = p.in[9]; const float* cb = p.in[10];
    const f32x4 b0 = *(const f32x4*)(cb + ch), b1 = *(const f32x4*)(cb + ch + 4);
    float a[8] = {b0[0], b0[1], b0[2], b0[3], b1[0], b1[1], b1[2], b1[3]};
#pragma unroll
    for (int t = 0; t < 4; ++t) {
        if (tpos - 3 + t >= 0) {
            const u32x4 raw = *(const u32x4*)(WSP(bf16, WS_PROJ) + (size_t)(tok - 3 + t) * LDP + C_X + ch);
            const f32x4 w0 = *(const f32x4*)(cw + t * 2048 + ch), w1 = *(const f32x4*)(cw + t * 2048 + ch + 4);
            a[0] += w0[0] * bflo(raw.x); a[1] += w0[1] * bfhi(raw.x); a[2] += w0[2] * bflo(raw.y); a[3] += w0[3] * bfhi(raw.y);
            a[4] += w1[0] * bflo(raw.z); a[5] += w1[1] * bfhi(raw.z); a[6] += w1[2] * bflo(raw.w); a[7] += w1[3] * bfhi(raw.w);
        }
    }
#pragma unroll
    for (int i = 0; i < 8; ++i) out[i] = silu_f(a[i]);
}


__device__ __forceinline__ void conv4x4(const Params& p, long tokc, int c, int j0, int ch, float (&o)[4][4]) {
    const float* cw = p.in[9]; const float* cb = p.in[10];
    u32x2 raw[7];
#pragma unroll
    for (int t = 0; t < 7; ++t) { raw[t] = (u32x2){0u, 0u};
        if (c * 128 + j0 - 3 + t >= 0) raw[t] = *(const u32x2*)(WSP(bf16, WS_PROJ) + (size_t)(tokc + j0 - 3 + t) * LDP + C_X + ch); }
    f32x4 w[4];
#pragma unroll
    for (int t = 0; t < 4; ++t) w[t] = *(const f32x4*)(cw + t * 2048 + ch);
    const f32x4 b0 = *(const f32x4*)(cb + ch);
#pragma unroll
    for (int q = 0; q < 4; ++q) {
        f32x4 a0 = b0;
#pragma unroll
        for (int t = 0; t < 4; ++t) { const u32x2 r = raw[q + t]; a0 = a0 + w[t] * (f32x4){bflo(r.x), bfhi(r.x), bflo(r.y), bfhi(r.y)}; }
#pragma unroll
        for (int i = 0; i < 4; ++i) o[q][i] = silu_f(a0[i]);
    }
}
__device__ __forceinline__ void store_t4(bf16* T, int row0, int tg, const float (&o)[4][4], float s0, float s1, float s2, float s3) {
    const int qp = tg ^ ((row0 >> 3) & 15);
#pragma unroll
    for (int i = 0; i < 4; ++i) { u32x2 w; w.x = pk2(o[0][i] * s0, o[1][i] * s1); w.y = pk2(o[2][i] * s2, o[3][i] * s3);
        *(u32x2*)(T + (row0 + i) * 136 + 4 * qp) = w; }
}
__device__ __forceinline__ bf16x8 load_t8(const bf16* T, int row, int ks, int hi) {
    const int sw = (row >> 3) & 15, qa = 4 * ks + 2 * hi;
    const u32x2 lo = *(const u32x2*)(T + row * 136 + 4 * (qa ^ sw)), h2 = *(const u32x2*)(T + row * 136 + 4 * ((qa + 1) ^ sw));
    const u32x4 w = {lo.x, lo.y, h2.x, h2.y};
    return __builtin_bit_cast(bf16x8, w);
}

__device__ __forceinline__ void attn_unit(const Params& p, const Ctx& F, int unit, unsigned char* lds) {
    const int tid = F.tid, lane = F.lane, wid = F.wid, l31 = lane & 31, hi = lane >> 5;
    const int kvh = unit & 3, blk = (unit >> 2) & 63, b = unit >> 8;
    bf16* Ks = (bf16*)lds;
    bf16* Vt = (bf16*)(lds + 36864);
    const bf16* proj = WSP(bf16, WS_PROJ);
    const long tok0 = (long)b * SEQ + (long)(blk - 1) * 128;
    u32x4 kvs[4], vvs[4];
#pragma unroll
    for (int it = 0; it < 4; ++it) {
        const int id = tid + it * 512, row = id >> 3, ch = id & 7;
        const bool ok = (blk > 0) || (row >= 128);
        kvs[it] = (u32x4){0u, 0u, 0u, 0u}; vvs[it] = (u32x4){0u, 0u, 0u, 0u};
        if (ok) { const bf16* src = proj + (size_t)(tok0 + row) * LDP; kvs[it] = *(const u32x4*)(src + C_K + kvh * 64 + ch * 8); vvs[it] = *(const u32x4*)(src + C_V + kvh * 64 + ch * 8); }
    }
#pragma unroll
    for (int it = 0; it < 4; ++it) {
        const int id = tid + it * 512, row = id >> 3, ch = id & 7;
        const u32x4 kv = kvs[it], vv = vvs[it];
        *(u32x4*)(Ks + row * 72 + ch * 8) = kv;
        bf16* vt = Vt + (ch * 8) * 260 + row;
        vt[0 * 260] = (bf16)(vv.x & 0xffffu); vt[1 * 260] = (bf16)(vv.x >> 16); vt[2 * 260] = (bf16)(vv.y & 0xffffu); vt[3 * 260] = (bf16)(vv.y >> 16);
        vt[4 * 260] = (bf16)(vv.z & 0xffffu); vt[5 * 260] = (bf16)(vv.z >> 16); vt[6 * 260] = (bf16)(vv.w & 0xffffu); vt[7 * 260] = (bf16)(vv.w >> 16);
    }
    __syncthreads();
    const int rh = wid >> 1, hq = wid & 1, h = kvh * 4 + rh;
    const float sink2 = p.in[15][h] * LOG2E, SC = 0.125f * LOG2E, NEG = -INFINITY;
    bf16x8 qall[2][4];
#pragma unroll
    for (int sb = 0; sb < 2; ++sb)
#pragma unroll
        for (int ks = 0; ks < 4; ++ks) qall[sb][ks] = *(const bf16x8*)(proj + (size_t)((long)b * SEQ + blk * 128 + hq * 64 + sb * 32 + l31) * LDP + C_Q + h * 64 + ks * 16 + hi * 8);
#pragma unroll 1
    for (int sb = 0; sb < 2; ++sb) {
        const int i0 = hq * 64 + sb * 32, jb0 = i0 >> 5;
        const long qtok = (long)b * SEQ + blk * 128 + i0 + l31;
        bf16x8 qf[4];
#pragma unroll
        for (int ks = 0; ks < 4; ++ks) qf[ks] = sb ? qall[1][ks] : qall[0][ks];
        f32x16 S[5];
#pragma unroll
        for (int jbi = 0; jbi < 5; ++jbi) {
            f32x16 a = {0.f, 0.f, 0.f, 0.f, 0.f, 0.f, 0.f, 0.f, 0.f, 0.f, 0.f, 0.f, 0.f, 0.f, 0.f, 0.f};
#pragma unroll
            for (int ks = 0; ks < 4; ++ks) { const bf16x8 kf = *(const bf16x8*)(Ks + (32 * (jb0 + jbi) + l31) * 72 + ks * 16 + hi * 8); a = MFMA32(kf, qf[ks], a); }
            S[jbi] = a;
        }
        float mx = NEG;
        if (blk > 0) {
#pragma unroll
            for (int r = 0; r < 16; ++r) { const int jj = crow(r, hi);
                S[0][r] = (jj > l31) ? S[0][r] : NEG; S[4][r] = (jj <= l31) ? S[4][r] : NEG; }
        } else {
            const int i = i0 + l31;
#pragma unroll
            for (int jbi = 0; jbi < 5; ++jbi)
#pragma unroll
                for (int r = 0; r < 16; ++r) { const int j = 32 * (jb0 + jbi) + crow(r, hi);
                    const bool valid = (j > i) && (j <= i + 128) && (j >= 128);
                    S[jbi][r] = valid ? S[jbi][r] : NEG; }
        }
#pragma unroll
        for (int jbi = 0; jbi < 5; ++jbi)
#pragma unroll
            for (int r = 0; r < 16; ++r) mx = fmaxf(mx, S[jbi][r]);
        mx = fmaxf(mx, __shfl_xor(mx, 32)); mx = fmaxf(mx * SC, sink2);
        float sum = 0.f;
#pragma unroll
        for (int jbi = 0; jbi < 5; ++jbi)
#pragma unroll
            for (int r = 0; r < 16; ++r) { const float e = __builtin_amdgcn_exp2f(__builtin_fmaf(S[jbi][r], SC, -mx)); S[jbi][r] = e; sum += e; }
        sum += __shfl_xor(sum, 32); sum += __builtin_amdgcn_exp2f(sink2 - mx);
        const float inv = 1.0f / sum;
        f32x16 o[2];
        o[0] = (f32x16){0.f, 0.f, 0.f, 0.f, 0.f, 0.f, 0.f, 0.f, 0.f, 0.f, 0.f, 0.f, 0.f, 0.f, 0.f, 0.f}; o[1] = o[0];
#pragma unroll
        for (int jbi = 0; jbi < 5; ++jbi)
#pragma unroll
            for (int s = 0; s < 2; ++s) {
                u32x4 pw; pw.x = pk2(S[jbi][8 * s + 0], S[jbi][8 * s + 1]); pw.y = pk2(S[jbi][8 * s + 2], S[jbi][8 * s + 3]); pw.z = pk2(S[jbi][8 * s + 4], S[jbi][8 * s + 5]); pw.w = pk2(S[jbi][8 * s + 6], S[jbi][8 * s + 7]);
                const bf16x8 pf = __builtin_bit_cast(bf16x8, pw);
                const int kb = 32 * (jb0 + jbi) + 16 * s + 4 * hi;
#pragma unroll
                for (int db = 0; db < 2; ++db) { const bf16* vr = Vt + (32 * db + l31) * 260 + kb;
                    const u32x2 lo = *(const u32x2*)vr, hh = *(const u32x2*)(vr + 8); const u32x4 vw = {lo.x, lo.y, hh.x, hh.y};
                    o[db] = MFMA32(__builtin_bit_cast(bf16x8, vw), pf, o[db]); }
            }
        bf16* orow = WSP(bf16, WS_MIX) + (size_t)qtok * DM + h * 64;
#pragma unroll
        for (int db = 0; db < 2; ++db)
#pragma unroll
            for (int rg = 0; rg < 4; ++rg) { u32x2 w; w.x = pk2(o[db][4 * rg] * inv, o[db][4 * rg + 1] * inv); w.y = pk2(o[db][4 * rg + 2] * inv, o[db][4 * rg + 3] * inv);
                *(u32x2*)(orow + 32 * db + 8 * rg + 4 * hi) = w; }
    }
    __syncthreads();
}

__device__ __forceinline__ void chunk_cumsum(const Params& p, const Ctx& F, long tokc, int g, float* csl, float* dtl, float* decay_out) {
    if (F.wid < 4) {
        const int lane = F.lane, hh = 4 * g + F.wid; const float a = -fexp(p.in[12][hh]);
        const float d0 = WSP(float, WS_DT)[(size_t)(tokc + 2 * lane) * 16 + hh], d1 = WSP(float, WS_DT)[(size_t)(tokc + 2 * lane + 1) * 16 + hh];
        const float x0 = d0 * a, x1 = x0 + d1 * a;
        float run = x1;
#pragma unroll
        for (int off = 1; off < 64; off <<= 1) { const float t = __shfl_up(run, off); if (lane >= off) run += t; }
        const float excl = run - x1;
        csl[F.wid * 128 + 2 * lane] = excl + x0; csl[F.wid * 128 + 2 * lane + 1] = excl + x1;
        dtl[F.wid * 128 + 2 * lane] = d0; dtl[F.wid * 128 + 2 * lane + 1] = d1;
        if (decay_out && lane == 63) decay_out[hh] = fexp(run);
    }
}

__device__ __forceinline__ void state_unit(const Params& p, const Ctx& F, int unit, unsigned char* lds) {
    const int tid = F.tid, lane = F.lane, wid = F.wid, l31 = lane & 31, hi = lane >> 5;
    const int g = unit & 3, c = (unit >> 2) & 63, b = unit >> 8;
    bf16* XwT = (bf16*)lds;
    bf16* BT = (bf16*)(lds + 69632);
    float* csl = (float*)(lds + 104448);
    float* dtl = csl + 512;
    const long tokc = (long)b * SEQ + c * 128;
    chunk_cumsum(p, F, tokc, g, csl, dtl, WSP(float, WS_DEC) + (size_t)(b * 64 + c) * 16);
    __syncthreads();
#pragma unroll 1
    for (int ps = 0; ps < 4; ++ps) {
        const int chunk = tid & 63, tg = (tid >> 6) + 8 * ps, hl = chunk >> 4;
        float o[4][4];
        conv4x4(p, tokc, c, 4 * tg, 256 * g + chunk * 4, o);
        const float ce = csl[hl * 128 + 127];
        const f32x4 dv = *(const f32x4*)(dtl + hl * 128 + 4 * tg), cv = *(const f32x4*)(csl + hl * 128 + 4 * tg);
        store_t4(XwT, chunk * 4, tg, o, dv[0] * fexp(ce - cv[0]), dv[1] * fexp(ce - cv[1]), dv[2] * fexp(ce - cv[2]), dv[3] * fexp(ce - cv[3]));
    }
#pragma unroll 1
    for (int ps = 0; ps < 2; ++ps) {
        const int chunk = tid & 31, tg = (tid >> 5) + 16 * ps;
        float o[4][4];
        conv4x4(p, tokc, c, 4 * tg, 1024 + 128 * g + chunk * 4, o);
        store_t4(BT, chunk * 4, tg, o, 1.f, 1.f, 1.f, 1.f);
    }
    __syncthreads();
    const int hl = wid >> 1, pb = wid & 1;
    f32x16 acc[4];
#pragma unroll
    for (int nb = 0; nb < 4; ++nb) acc[nb] = (f32x16){0.f, 0.f, 0.f, 0.f, 0.f, 0.f, 0.f, 0.f, 0.f, 0.f, 0.f, 0.f, 0.f, 0.f, 0.f, 0.f};
#pragma unroll
    for (int ks = 0; ks < 8; ++ks) {
        const bf16x8 af = load_t8(XwT, hl * 64 + 32 * pb + l31, ks, hi);
#pragma unroll
        for (int nb = 0; nb < 4; ++nb) { const bf16x8 bf = load_t8(BT, 32 * nb + l31, ks, hi); acc[nb] = MFMA32(af, bf, acc[nb]); }
        if (ks & 1) asm volatile("" ::: "memory");
    }
    bf16* st = (bf16*)(p.out + OS_STATES) + ((size_t)((b * 64 + c) * 16 + 4 * g + hl) * 64) * 128;
    const bool odd = (l31 & 1) != 0;
#pragma unroll
    for (int nb = 0; nb < 4; ++nb)
#pragma unroll
        for (int r = 0; r < 16; r += 2) {
            const float a = acc[nb][r], b2 = acc[nb][r + 1];
            const float recv = __shfl_xor(odd ? a : b2, 1);
            const unsigned w = odd ? pk2(recv, b2) : pk2(a, recv);
            *(unsigned*)(st + (size_t)(32 * pb + crow(odd ? r + 1 : r, hi)) * 128 + 32 * nb + (l31 & ~1)) = w;
        }
    __syncthreads();
}

__device__ __forceinline__ void sample_unit(const Params& p, const Ctx& F, int b, int sp, unsigned char* lds) {
    const int tid = F.tid, lane = F.lane, wid = F.wid;
    float* qs = (float*)lds;
    float* sc = qs + 1024;
    float* xbc = sc + 2048;
    float* ys = xbc + 2048;
    float* part = ys + 1024;
    const size_t row = 16384 + b;
    const bf16* prow = WSP(bf16, WS_PROJ) + row * LDP;
    float* out = p.out;
    if (sp == 0) for (int i = tid; i < 1024; i += 512) qs[i] = bf2f(prow[C_Q + i]);
    if (sp == 1) {
        const int ch = tid * 4;
        const float* cst = p.in[5] + (size_t)b * 3 * 2048 + ch;
        const f32x4 c0 = *(const f32x4*)cst, c1 = *(const f32x4*)(cst + 2048), c2 = *(const f32x4*)(cst + 4096);
        const u32x2 raw = *(const u32x2*)(prow + C_X + ch);
        const f32x4 xin = {bflo(raw.x), bfhi(raw.x), bflo(raw.y), bfhi(raw.y)};
        const float* cw = p.in[9] + ch;
        const f32x4 w0 = *(const f32x4*)cw, w1 = *(const f32x4*)(cw + 2048), w2 = *(const f32x4*)(cw + 4096), w3 = *(const f32x4*)(cw + 6144);
        const f32x4 a = *(const f32x4*)(p.in[10] + ch) + w0 * c0 + w1 * c1 + w2 * c2 + w3 * xin;
        f32x4 o; o[0] = silu_f(a[0]); o[1] = silu_f(a[1]); o[2] = silu_f(a[2]); o[3] = silu_f(a[3]);
        *(f32x4*)(xbc + ch) = o;
        float* nc = out + O_CONVS + (size_t)b * 3 * 2048 + ch;
        *(f32x4*)nc = c1; *(f32x4*)(nc + 2048) = c2; *(f32x4*)(nc + 4096) = xin;
    }
    __syncthreads();
    if (sp == 0) {
    {
        const int kvh = tid >> 7, c = tid & 127;
        float d0 = 0.f, d1 = 0.f, d2 = 0.f, d3 = 0.f;
        float* nk = out + O_KS + (((size_t)b * 128 + c) * 4 + kvh) * 64;
        const float* qb = qs + kvh * 256;
        if (c < 127) {
            const float* kr = p.in[2] + (((size_t)b * 128 + c + 1) * 4 + kvh) * 64;
#pragma unroll 1
            for (int h8 = 0; h8 < 16; h8 += 8) {
                f32x4 kvv[8];
#pragma unroll
                for (int q = 0; q < 8; ++q) kvv[q] = ((const f32x4*)kr)[h8 + q];
#pragma unroll
                for (int q = 0; q < 8; ++q) { const int d4 = h8 + q; const f32x4 kv = kvv[q]; ((f32x4*)nk)[d4] = kv;
#pragma unroll
                    for (int j = 0; j < 4; ++j) { const float k = kv[j]; const int d = 4 * d4 + j; d0 += k * qb[d]; d1 += k * qb[64 + d]; d2 += k * qb[128 + d]; d3 += k * qb[192 + d]; } }
            }
        } else {
            const bf16* kr = prow + C_K + kvh * 64;
#pragma unroll 4
            for (int d4 = 0; d4 < 16; ++d4) { const u32x2 raw = *(const u32x2*)(kr + 4 * d4); const f32x4 kv = {bflo(raw.x), bfhi(raw.x), bflo(raw.y), bfhi(raw.y)}; ((f32x4*)nk)[d4] = kv;
#pragma unroll
                for (int j = 0; j < 4; ++j) { const float k = kv[j]; const int d = 4 * d4 + j; d0 += k * qb[d]; d1 += k * qb[64 + d]; d2 += k * qb[128 + d]; d3 += k * qb[192 + d]; } }
        }
        sc[(kvh * 4 + 0) * 128 + c] = d0 * 0.125f; sc[(kvh * 4 + 1) * 128 + c] = d1 * 0.125f; sc[(kvh * 4 + 2) * 128 + c] = d2 * 0.125f; sc[(kvh * 4 + 3) * 128 + c] = d3 * 0.125f;
    }
    __syncthreads();
#pragma unroll
    for (int hh = 0; hh < 2; ++hh) {
        const int h = 2 * wid + hh; const float s0 = sc[h * 128 + lane], s1 = sc[h * 128 + 64 + lane], sink = p.in[15][h];
        const float m = fmaxf(wave_max(fmaxf(s0, s1)), sink);
        const float e0 = fexp(s0 - m), e1 = fexp(s1 - m);
        const float inv = 1.0f / (wave_sum(e0 + e1) + fexp(sink - m));
        sc[h * 128 + lane] = e0 * inv; sc[h * 128 + 64 + lane] = e1 * inv;
    }
    __syncthreads();
    {
        const int kg = tid >> 6, kvh = (tid >> 4) & 3, d4 = tid & 15;
        f32x4 a0 = {0.f, 0.f, 0.f, 0.f}, a1 = a0, a2 = a0, a3 = a0;
#pragma unroll 1
        for (int cb = 0; cb < 16; cb += 8) {
            f32x4 vv[8];
#pragma unroll
            for (int ci = 0; ci < 8; ++ci) { const int c = kg * 16 + cb + ci;
                if (c < 127) vv[ci] = *(const f32x4*)(p.in[3] + (((size_t)b * 128 + c + 1) * 4 + kvh) * 64 + 4 * d4);
                else { const u32x2 raw = *(const u32x2*)(prow + C_V + kvh * 64 + 4 * d4); vv[ci] = (f32x4){bflo(raw.x), bfhi(raw.x), bflo(raw.y), bfhi(raw.y)}; } }
#pragma unroll
            for (int ci = 0; ci < 8; ++ci) { const int c = kg * 16 + cb + ci;
                *(f32x4*)(out + O_VS + (((size_t)b * 128 + c) * 4 + kvh) * 64 + 4 * d4) = vv[ci];
                const float* pr = sc + (kvh * 4) * 128 + c;
                a0 = a0 + vv[ci] * pr[0]; a1 = a1 + vv[ci] * pr[128]; a2 = a2 + vv[ci] * pr[256]; a3 = a3 + vv[ci] * pr[384]; }
        }
        float* pp = ys + 1024 + 16;
        float* pd = pp + (kg * 16 + kvh * 4) * 64 + 4 * d4;
        *(f32x4*)pd = a0; *(f32x4*)(pd + 64) = a1; *(f32x4*)(pd + 128) = a2; *(f32x4*)(pd + 192) = a3;
        __syncthreads();
        const int h = tid >> 5, d = 2 * (tid & 31);
        float o0 = 0.f, o1 = 0.f;
#pragma unroll
        for (int k = 0; k < 8; ++k) { const f32x2 t = *(const f32x2*)(pp + (k * 16 + h) * 64 + d); o0 += t[0]; o1 += t[1]; }
        *(unsigned*)(WSP(bf16, WS_MIX) + row * DM + h * 64 + d) = pk2(o0, o1);
    }
    } else {
    {
        const int half = lane >> 5, l4 = (lane & 31) * 4;
#pragma unroll 1
        for (int k = 0; k < 128; k += 8) {
            const int id0 = wid * 128 + k, h = id0 >> 6, g = h >> 2;
            const float dtv = WSP(float, WS_DT)[row * 16 + h], dA = fexp(-dtv * fexp(p.in[12][h])), dsk = p.in[13][h];
            const f32x4 Bn = *(const f32x4*)(xbc + 1024 + g * 128 + l4), Cn = *(const f32x4*)(xbc + 1536 + g * 128 + l4);
            f32x4 st[4];
#pragma unroll
            for (int u = 0; u < 4; ++u) { const int pp = (id0 & 63) + 2 * u + half; st[u] = *(const f32x4*)(p.in[4] + (((size_t)b * 16 + h) * 64 + pp) * 128 + l4); }
#pragma unroll
            for (int u = 0; u < 4; ++u) { const int pp = (id0 & 63) + 2 * u + half;
                const float xv = xbc[h * 64 + pp], xd = xv * dtv;
                const f32x4 nw = st[u] * dA + Bn * xd;
                *(f32x4*)(out + O_SSMS + (((size_t)b * 16 + h) * 64 + pp) * 128 + l4) = nw;
                float yp = (nw[0] * Cn[0] + nw[1] * Cn[1]) + (nw[2] * Cn[2] + nw[3] * Cn[3]);
#pragma unroll
                for (int o = 1; o < 32; o <<= 1) yp += __shfl_xor(yp, o);
                if ((lane & 31) == 0) ys[h * 64 + pp] = yp + dsk * xv; }
        }
    }
    __syncthreads();
    {
        float v[2];
#pragma unroll
        for (int q = 0; q < 2; ++q) { const int ch = tid + 512 * q; v[q] = ys[ch] * silu_f(bf2f(prow[C_Z + ch])); const float s = wave_sum(v[q] * v[q]); if (lane == 0) part[wid * 2 + q] = s; }
        __syncthreads();
        const int wb = (wid >> 2) * 4;
#pragma unroll
        for (int q = 0; q < 2; ++q) { const int ch = tid + 512 * q;
            const float tot = (part[(wb + 0) * 2 + q] + part[(wb + 1) * 2 + q]) + (part[(wb + 2) * 2 + q] + part[(wb + 3) * 2 + q]);
            const float rs = 1.0f / sqrtf(tot * (1.0f / 256.0f) + EPS);
            WSP(bf16, WS_MIX)[row * DM + 1024 + ch] = (bf16)f2bf(v[q] * rs * p.in[14][ch]); }
    }
    }
    __syncthreads();
}

__device__ __forceinline__ void scan_phase(const Params& p, const Ctx& F) {
    const int gt = blockIdx.x * 512 + F.tid, NT = gridDim.x * 512;
    for (int idx = gt; idx < 131072; idx += NT) {
        const int n2 = idx & 63, pp = (idx >> 6) & 63, hh = (idx >> 12) & 15, b = idx >> 16;
        float s0 = 0.f, s1 = 0.f;
#pragma unroll 1
        for (int c0 = 0; c0 < 64; c0 += 8) {
            unsigned st[8]; float dc[8];
#pragma unroll
            for (int k = 0; k < 8; ++k) { const size_t off = ((size_t)((b * 64 + c0 + k) * 16 + hh) * 64 + pp) * 128 + 2 * n2;
                st[k] = *(const unsigned*)((const bf16*)(p.out + OS_STATES) + off); dc[k] = WSP(float, WS_DEC)[(b * 64 + c0 + k) * 16 + hh]; }
#pragma unroll
            for (int k = 0; k < 8; ++k) { const size_t off = ((size_t)((b * 64 + c0 + k) * 16 + hh) * 64 + pp) * 128 + 2 * n2;
                *(unsigned*)(((bf16*)(p.out + OS_PREV)) + off) = pk2(s0, s1);
                s0 = s0 * dc[k] + bflo(st[k]); s1 = s1 * dc[k] + bfhi(st[k]); }
        }
        f32x2 fin; fin[0] = s0; fin[1] = s1;
        *(f32x2*)(p.out + O_SSMP + ((size_t)(b * 16 + hh) * 64 + pp) * 128 + 2 * n2) = fin;
    }
}


template <bool DIAG> __device__ __forceinline__ void ssd_jb(f32x16 (&acc)[2], const f32x16& cb, int jb, const float* cslh, float cs_i, float ddt, int irel, int hi, const bf16* XdTh, int swb) {
    const int l31 = threadIdx.x & 31;
#pragma unroll
    for (int s = 0; s < 2; ++s) {
        float mv[8];
#pragma unroll
        for (int t = 0; t < 8; ++t) { const int r = 8 * s + t, jj = crow(r, hi);
            float m = cb[r] * fexp(cs_i - cslh[32 * jb + jj]);
            if (DIAG) { m = (jj <= irel) ? m : 0.f; m += (jj == irel) ? ddt : 0.f; }
            mv[t] = m; }
        u32x4 mw; mw.x = pk2(mv[0], mv[1]); mw.y = pk2(mv[2], mv[3]); mw.z = pk2(mv[4], mv[5]); mw.w = pk2(mv[6], mv[7]);
        const bf16x8 mf = __builtin_bit_cast(bf16x8, mw);
        const int kb = 32 * jb + 16 * s + 4 * hi;
#pragma unroll
        for (int pb = 0; pb < 2; ++pb) { const bf16* xr = XdTh + (32 * pb + l31) * 136; const int sw = (swb + 4 * pb + (l31 >> 3)) & 15, q0 = kb >> 2;
            const u32x2 lo = *(const u32x2*)(xr + 4 * (q0 ^ sw)), h2 = *(const u32x2*)(xr + 4 * ((q0 + 2) ^ sw)); const u32x4 xw = {lo.x, lo.y, h2.x, h2.y};
            acc[pb] = MFMA32(__builtin_bit_cast(bf16x8, xw), mf, acc[pb]); }
    }
}

__device__ __forceinline__ void ssdy_unit(const Params& p, const Ctx& F, int unit, unsigned char* lds) {
    const int tid = F.tid, lane = F.lane, wid = F.wid, l31 = lane & 31, hi = lane >> 5;
    const int g = unit & 3, c = (unit >> 2) & 63, b = unit >> 8;
    bf16* Cs = (bf16*)lds;
    bf16* Bs = (bf16*)(lds + 34816);
    bf16* XdT = (bf16*)(lds + 34816);
    float* csl = (float*)(lds + 104448);
    float* dtl = csl + 512;
    float* red = dtl + 512;
    const long tokc = (long)b * SEQ + c * 128;
    chunk_cumsum(p, F, tokc, g, csl, dtl, nullptr);
#pragma unroll 1
    for (int ps = 0; ps < 4; ++ps) {
        const int which = ps >> 1, chunk = tid & 31, tg = (tid >> 5) + 16 * (ps & 1);
        float o[4][4];
        conv4x4(p, tokc, c, 4 * tg, 1024 + 512 * which + 128 * g + chunk * 4, o);
        bf16* dst = (which ? Cs : Bs) + (4 * tg) * 136 + chunk * 4;
#pragma unroll
        for (int q = 0; q < 4; ++q) { u32x2 w; w.x = pk2(o[q][0], o[q][1]); w.y = pk2(o[q][2], o[q][3]); *(u32x2*)(dst + q * 136) = w; }
    }
    __syncthreads();
    const int ib = wid & 3, hp = wid >> 2;
    f32x16 CBt[4];
#pragma unroll
    for (int jb = 0; jb < 4; ++jb) {
        CBt[jb] = (f32x16){0.f, 0.f, 0.f, 0.f, 0.f, 0.f, 0.f, 0.f, 0.f, 0.f, 0.f, 0.f, 0.f, 0.f, 0.f, 0.f};
        if (jb <= ib) {
#pragma unroll
            for (int ks = 0; ks < 8; ++ks) {
                const bf16x8 bfr = *(const bf16x8*)(Bs + (32 * jb + l31) * 136 + 16 * ks + 8 * hi);
                const bf16x8 cfr = *(const bf16x8*)(Cs + (32 * ib + l31) * 136 + 16 * ks + 8 * hi);
                CBt[jb] = MFMA32(bfr, cfr, CBt[jb]);
            }
        }
    }
    __syncthreads();
#pragma unroll 1
    for (int ps = 0; ps < 4; ++ps) {
        const int chunk = tid & 63, tg = (tid >> 6) + 8 * ps, hl = chunk >> 4;
        float o[4][4];
        conv4x4(p, tokc, c, 4 * tg, 256 * g + chunk * 4, o);
        const f32x4 dv = *(const f32x4*)(dtl + hl * 128 + 4 * tg);
        store_t4(XdT, chunk * 4, tg, o, dv[0], dv[1], dv[2], dv[3]);
    }
    __syncthreads();
    const int i = 32 * ib + l31;
    const size_t tok = (size_t)(tokc + i);
    float sq = 0.f;
#pragma unroll 1
    for (int hh2 = 0; hh2 < 2; ++hh2) {
        const int hl = 2 * hp + hh2, hg = 4 * g + hl;
        int l31h = l31; asm volatile("" : "+v"(l31h));
        const float cs_i = csl[hl * 128 + i], ddt = p.in[13][hg] / dtl[hl * 128 + i], e_i = fexp(cs_i);
        f32x16 acc[2];
        acc[0] = (f32x16){0.f, 0.f, 0.f, 0.f, 0.f, 0.f, 0.f, 0.f, 0.f, 0.f, 0.f, 0.f, 0.f, 0.f, 0.f, 0.f}; acc[1] = acc[0];
        const bf16* pv = ((bf16*)(p.out + OS_PREV)) + ((size_t)((b * 64 + c) * 16 + hg) * 64) * 128;
#pragma unroll
        for (int ks = 0; ks < 8; ++ks) {
            const bf16x8 cfr = *(const bf16x8*)(Cs + (32 * ib + l31) * 136 + 16 * ks + 8 * hi);
#pragma unroll
            for (int pb = 0; pb < 2; ++pb) { const bf16x8 pf = *(const bf16x8*)(pv + (size_t)(32 * pb + l31) * 128 + 16 * ks + 8 * hi); acc[pb] = MFMA32(pf, cfr, acc[pb]); }
            if ((ks & 3) == 3) asm volatile("" ::: "memory");
        }
#pragma unroll
        for (int pb = 0; pb < 2; ++pb)
#pragma unroll
            for (int r = 0; r < 16; ++r) acc[pb][r] *= e_i;
#pragma unroll
        for (int jb = 0; jb < 4; ++jb) {
            if (jb <= ib) ssd_jb<true>(acc, CBt[jb], jb, csl + hl * 128, cs_i, ddt, l31h + 32 * (ib - jb), hi, XdT + (hl * 64) * 136, (hl & 1) * 8);
        }
        const bf16* zr = WSP(bf16, WS_PROJ) + tok * LDP + C_Z + hg * 64;
        bf16* orow = WSP(bf16, WS_MIX) + tok * DM + 1024 + hg * 64;
        u32x2 zv[2][4];
#pragma unroll
        for (int pb = 0; pb < 2; ++pb)
#pragma unroll
            for (int rg = 0; rg < 4; ++rg) zv[pb][rg] = *(const u32x2*)(zr + 32 * pb + 8 * rg + 4 * hi);
#pragma unroll
        for (int pb = 0; pb < 2; ++pb)
#pragma unroll
            for (int rg = 0; rg < 4; ++rg) {
                const int d = 32 * pb + 8 * rg + 4 * hi;
                const u32x2 zw = zv[pb][rg];
                const float v0 = acc[pb][4 * rg + 0] * silu_f(bflo(zw.x)), v1 = acc[pb][4 * rg + 1] * silu_f(bfhi(zw.x));
                const float v2 = acc[pb][4 * rg + 2] * silu_f(bflo(zw.y)), v3 = acc[pb][4 * rg + 3] * silu_f(bfhi(zw.y));
                u32x2 w; w.x = pk2(v0, v1); w.y = pk2(v2, v3);
                const float q0 = bflo(w.x), q1 = bfhi(w.x), q2 = bflo(w.y), q3 = bfhi(w.y);
                sq += (q0 * q0 + q1 * q1) + (q2 * q2 + q3 * q3);
                *(u32x2*)(orow + d) = w;
            }
    }
    sq += __shfl_xor(sq, 32);
    if (hi == 0) red[hp * 128 + i] = sq;
    __syncthreads();
    const float rs = 1.0f / sqrtf((red[i] + red[128 + i]) * (1.0f / 256.0f) + EPS);
#pragma unroll 1
    for (int hh2 = 0; hh2 < 2; ++hh2) {
        const int hg = 4 * g + 2 * hp + hh2;
        const float* gn = p.in[14] + hg * 64;
        bf16* orow = WSP(bf16, WS_MIX) + tok * DM + 1024 + hg * 64;
        f32x4 gvv[2][4]; u32x2 wv[2][4];
#pragma unroll
        for (int pb = 0; pb < 2; ++pb)
#pragma unroll
            for (int rg = 0; rg < 4; ++rg) { const int d = 32 * pb + 8 * rg + 4 * hi; gvv[pb][rg] = *(const f32x4*)(gn + d); wv[pb][rg] = *(const u32x2*)(orow + d); }
#pragma unroll
        for (int pb = 0; pb < 2; ++pb)
#pragma unroll
            for (int rg = 0; rg < 4; ++rg) {
                const int d = 32 * pb + 8 * rg + 4 * hi; const f32x4 gv = gvv[pb][rg];
                const u32x2 w0 = wv[pb][rg];
                u32x2 w; w.x = pk2(bflo(w0.x) * rs * gv[0], bfhi(w0.x) * rs * gv[1]); w.y = pk2(bflo(w0.y) * rs * gv[2], bfhi(w0.y) * rs * gv[3]);
                *(u32x2*)(orow + d) = w;
            }
    }
    __syncthreads();
}


#define MFMA16(a, b, c) __builtin_amdgcn_mfma_f32_16x16x32_bf16((a), (b), (c), 0, 0, 0)
template <int NB> __device__ __forceinline__ void skinny_acc(f32x4 (&res)[NB], const bf16* A, int lda, const bf16* B0, const bf16* B1, int ldb, int K, unsigned char* lds, const Ctx& F) {
    const int lane = F.lane, wid = F.wid, fr = lane & 15, fq = lane >> 4;
    const int kper = K >> 3;
    f32x4 acc[NB][4];
#pragma unroll
    for (int nb = 0; nb < NB; ++nb)
#pragma unroll
        for (int m = 0; m < 4; ++m) acc[nb][m] = (f32x4){0.f, 0.f, 0.f, 0.f};
    const bf16* ap = A + (size_t)fr * lda + wid * kper + 8 * fq;
    const bf16* bp0 = B0 + (size_t)fr * ldb + wid * kper + 8 * fq;
    const bf16* bp1 = B1 + (size_t)fr * ldb + wid * kper + 8 * fq;
#pragma unroll 8
    for (int k = 0; k < kper; k += 32) {
        const bf16x8 b0 = *(const bf16x8*)(bp0 + k);
        bf16x8 b1 = b0; if (NB == 2) b1 = *(const bf16x8*)(bp1 + k);
#pragma unroll
        for (int m = 0; m < 4; ++m) { const bf16x8 a = *(const bf16x8*)(ap + (size_t)(16 * m) * lda + k);
            acc[0][m] = MFMA16(b0, a, acc[0][m]); if (NB == 2) acc[NB - 1][m] = MFMA16(b1, a, acc[NB - 1][m]); }
    }
    f32x4* red = (f32x4*)lds;
#pragma unroll
    for (int nb = 0; nb < NB; ++nb)
#pragma unroll
        for (int m = 0; m < 4; ++m) red[((wid * NB + nb) * 4 + m) * 64 + lane] = acc[nb][m];
    __syncthreads();
    if (F.tid < 256) {
#pragma unroll
        for (int nb = 0; nb < NB; ++nb) { f32x4 s = {0.f, 0.f, 0.f, 0.f};
#pragma unroll
            for (int w = 0; w < 8; ++w) s = s + red[((w * NB + nb) * 4 + wid) * 64 + lane];
            res[nb] = s; }
    }
}
__device__ __forceinline__ void s1_unit(const Params& p, const Ctx& F, int unit, unsigned char* lds) {
    const int rh = unit & 1, c0 = (unit >> 1) * 16, fr = F.lane & 15, fq = F.lane >> 4;
    f32x4 v[1];
    skinny_acc<1>(v, WSP(bf16, WS_U) + (size_t)(16384 + 64 * rh) * DM, DM, WSP(bf16, WS_WIN) + (size_t)c0 * DM, nullptr, DM, DM, lds, F);
    if (F.tid < 256) {
        const size_t row = 16384 + 64 * rh + 16 * F.wid + fr;
        f32x4 x = v[0] * WSP(float, WS_R0)[row];
        if (c0 < 1280 && (c0 & 63) == 0) {
            const float* t = WSP(float, WS_TAB) + (size_t)8192 * 16 + 4 * (fq & 1);
            const f32x4 cs = *(const f32x4*)t, sn = *(const f32x4*)(t + 8);
            f32x4 o;
#pragma unroll
            for (int j = 0; j < 4; ++j) o[j] = __shfl_xor(x[j], 32);
            x = (fq < 2) ? (x * cs - o * sn) : (x * cs + o * sn);
        }
        u32x2 w; w.x = pk2(x[0], x[1]); w.y = pk2(x[2], x[3]);
        *(u32x2*)(WSP(bf16, WS_PROJ) + row * LDP + c0 + 4 * fq) = w;
        if (c0 == C_DT) { const float* bb = p.in[11] + 4 * fq; f32x4 d;
#pragma unroll
            for (int j = 0; j < 4; ++j) d[j] = pg8::softplus_f(x[j] + bb[j]);
            *(f32x4*)(WSP(float, WS_DT) + row * 16 + 4 * fq) = d; }
    }
    __syncthreads();
}
__device__ __forceinline__ void s_res_epilogue(const Params& p, const Ctx& F, f32x4 v, f32x4 base, size_t row, int c, float* ss) {
    const f32x4 h = base + v;
    u32x2 w; w.x = pk2(h[0], h[1]); w.y = pk2(h[2], h[3]);
    *(u32x2*)(WSP(bf16, WS_U) + row * DM + c) = w;
    float sq = (h[0] * h[0] + h[1] * h[1]) + (h[2] * h[2] + h[3] * h[3]);
    sq += __shfl_xor(sq, 16); sq += __shfl_xor(sq, 32);
    if ((F.lane >> 4) == 0) atomicAdd(ss + row, sq);
}
__device__ __forceinline__ void s2_unit(const Params& p, const Ctx& F, int unit, unsigned char* lds) {
    const int rh = unit & 1, c0 = (unit >> 1) * 16, fr = F.lane & 15, fq = F.lane >> 4;
    f32x4 v[1];
    skinny_acc<1>(v, WSP(bf16, WS_MIX) + (size_t)(16384 + 64 * rh) * DM, DM, WSP(bf16, WS_WO) + (size_t)c0 * DM, nullptr, DM, DM, lds, F);
    if (F.tid < 256) { const size_t srow = 64 * rh + 16 * F.wid + fr; const int c = c0 + 4 * fq;
        const u32x2 hb = *(const u32x2*)(WSP(bf16, WS_U) + (16384 + srow) * DM + c);
        s_res_epilogue(p, F, v[0], (f32x4){bflo(hb.x), bfhi(hb.x), bflo(hb.y), bfhi(hb.y)}, 16384 + srow, c, WSP(float, WS_SS1)); }
    __syncthreads();
}
__device__ __forceinline__ void s3_unit(const Params& p, const Ctx& F, int unit, unsigned char* lds) {
    const int rh = unit & 1, hc0 = (unit >> 1) * 16, fr = F.lane & 15, fq = F.lane >> 4;
    const bf16* Bg = WSP(bf16, WS_WGU) + (size_t)((hc0 >> 7) * 256 + (hc0 & 127)) * DM;
    f32x4 v[2];
    skinny_acc<2>(v, WSP(bf16, WS_U) + (size_t)(16384 + 64 * rh) * DM, DM, Bg, Bg + (size_t)128 * DM, DM, DM, lds, F);
    if (F.tid < 256) { const size_t row = 16384 + 64 * rh + 16 * F.wid + fr;
        const float r = 1.0f / sqrtf(WSP(float, WS_SS1)[row] * (1.0f / DM) + EPS);
        f32x4 h;
#pragma unroll
        for (int j = 0; j < 4; ++j) { const float g = v[0][j] * r; h[j] = g * pg8::sigmoid_f(g) * (v[1][j] * r); }
        u32x2 w; w.x = pk2(h[0], h[1]); w.y = pk2(h[2], h[3]);
        *(u32x2*)(WSP(bf16, WS_PROJ) + row * FF + hc0 + 4 * fq) = w; }
    __syncthreads();
}
__device__ __forceinline__ void s4_unit(const Params& p, const Ctx& F, int unit, unsigned char* lds) {
    const int rh = unit & 1, c0 = (unit >> 1) * 16, fr = F.lane & 15, fq = F.lane >> 4;
    f32x4 v[1];
    skinny_acc<1>(v, WSP(bf16, WS_PROJ) + (size_t)(16384 + 64 * rh) * FF, FF, WSP(bf16, WS_WD) + (size_t)c0 * FF, nullptr, FF, FF, lds, F);
    if (F.tid < 256) { const size_t row = 16384 + 64 * rh + 16 * F.wid + fr; const int c = c0 + 4 * fq;
        const u32x2 hb = *(const u32x2*)(WSP(bf16, WS_U) + row * DM + c);
        s_res_epilogue(p, F, v[0], (f32x4){bflo(hb.x), bfhi(hb.x), bflo(hb.y), bfhi(hb.y)}, row, c, WSP(float, WS_SS2)); }
    __syncthreads();
}
__device__ __forceinline__ void s5_unit(const Params& p, const Ctx& F, int unit, unsigned char* lds) {
    const int rh = unit & 1, c0 = (unit >> 1) * 16, fr = F.lane & 15, fq = F.lane >> 4;
    f32x4 vg[1], vp[1];
    skinny_acc<1>(vg, WSP(bf16, WS_U) + (size_t)(16384 + 64 * rh) * DM, DM, WSP(bf16, WS_WPG) + (size_t)c0 * DM, nullptr, DM, DM, lds, F);
    __syncthreads();
    skinny_acc<1>(vp, WSP(bf16, WS_PB) + (size_t)(16384 + 64 * rh) * 256, 256, WSP(bf16, WS_WP) + (size_t)c0 * 256, nullptr, 256, 256, lds, F);
    if (F.tid < 256) { const size_t row = 16384 + 64 * rh + 16 * F.wid + fr;
        const float r = 1.0f / sqrtf(WSP(float, WS_SS2)[row] * (1.0f / DM) + EPS);
        const size_t ho = row * DM + c0 + 4 * fq;
        const u32x2 hb = *(const u32x2*)(WSP(bf16, WS_U) + ho);
        f32x4 h = {bflo(hb.x), bfhi(hb.x), bflo(hb.y), bfhi(hb.y)};
#pragma unroll
        for (int j = 0; j < 4; ++j) h[j] += vp[0][j] * pg8::sigmoid_f(vg[0][j] * r);
        u32x2 w; w.x = pk2(h[0], h[1]); w.y = pk2(h[2], h[3]);
        *(u32x2*)(WSP(bf16, WS_H3) + ho) = w; }
    __syncthreads();
}

template <int WGM_ = 4, class Epi> __device__ __forceinline__ void run_gemm(PG8_LAS unsigned char* lds, const bf16* A, const bf16* Bt, int M, int N, int K, const Epi& E) {
    pg8::Gemm g{A, Bt, M, N, K}; pg8::StaticOrder S; S.init(M, N, (int)gridDim.x, (int)blockIdx.x, WGM_);
    pg8::gemm_phase<Epi, pg8::StaticOrder, true, true>(lds, g, S, E);
}

#ifndef PHMASK
#define PHMASK 0xffff
#endif
constexpr int LDS_BYTES = 147456;
__global__ void __launch_bounds__(512, 2) mega_fwd(Params p) {
    extern __shared__ __attribute__((aligned(16))) unsigned char lds[];
    cg::grid_group grid = cg::this_grid();
    PG8_LAS unsigned char* lds3 = (PG8_LAS unsigned char*)lds;
    const int G = gridDim.x;
    volatile LAS unsigned* MISC = (volatile LAS unsigned*)(lds3 + 131072 + 320);
    if (threadIdx.x < 32) MISC[threadIdx.x] = 0u;
    unsigned* barw = (unsigned*)(p.ws + WS_BAR);
    unsigned* readyw = barw + XCD_BAR_WORDS + 64;
    constexpr unsigned RDY = 0x13579BDFu, DONE = 0x2468ACE0u;
    if (blockIdx.x == 0) {
        for (int i = threadIdx.x; i < XCD_BAR_WORDS; i += 512) barw[i] = 0u;
        asm volatile("s_waitcnt vmcnt(0)" ::: "memory");
        __syncthreads();
        if (threadIdx.x == 0) { __builtin_amdgcn_fence(__ATOMIC_RELEASE, "agent"); asm volatile("s_waitcnt vmcnt(0)" ::: "memory"); __hip_atomic_store(readyw, RDY, __ATOMIC_RELAXED, __HIP_MEMORY_SCOPE_AGENT); }
    }
    __syncthreads();

    if (PHMASK & 1) { const Ctx F = mk_ctx(); p0_prologue(p, F, lds); }
    if (p.ws == nullptr) grid.sync();
    if (threadIdx.x == 0) {
        unsigned sp = 0u;
        while (__hip_atomic_load(readyw, __ATOMIC_RELAXED, __HIP_MEMORY_SCOPE_AGENT) != RDY) { __builtin_amdgcn_s_sleep(2); if (++sp > (1u << 22)) break; }
        __builtin_amdgcn_fence(__ATOMIC_ACQUIRE, "agent");
    }
    __syncthreads();
    const XcdBarrier xbar = xcd_barrier_post(barw, MISC + 8);
    xcd_barrier(xbar);
    if (PHMASK & 2) { pg8::EpiProj E{WSP(bf16, WS_PROJ), WSP(float, WS_DT), WSP(float, WS_TAB), p.in[11], WSP(float, WS_R0)}; run_gemm(lds3, WSP(bf16, WS_U), WSP(bf16, WS_WIN), 16384, LDP, 2048, E); }
    { const Ctx F = mk_ctx(); const bool bal = (G == 256);
      if (!bal || blockIdx.x >= 192) for (int it = bal ? (int)blockIdx.x - 192 : (int)blockIdx.x; it < 578; it += (bal ? 64 : G)) s1_unit(p, F, it, lds); }
    xcd_barrier(xbar);
    if (PHMASK & 0x4000) { const Ctx F = mk_ctx(); for (int it = blockIdx.x; it < 256; it += G) sample_unit(p, F, it & 127, it >> 7, lds); }
    if (PHMASK & 0x1000) { const Ctx F = mk_ctx(); for (int it = blockIdx.x; it < 512; it += G) attn_unit(p, F, it, lds); }
    if (PHMASK & 0x2000) { const Ctx F = mk_ctx(); for (int it = blockIdx.x; it < 512; it += G) state_unit(p, F, it, lds); }
    { const Ctx F = mk_ctx(); const int gt = blockIdx.x * 512 + F.tid, NT = G * 512;
    for (int i = gt; i < 2 * 128 * 512; i += NT) {
        const int col = i & 511, w = (i >> 9) & 127, b = i >> 16;
        const float v = bf2f(WSP(bf16, WS_PROJ)[(size_t)(b * SEQ + SEQ - 128 + w) * LDP + C_K + col]);
        if (col < 256) p.out[O_KP + (size_t)(b * 128 + w) * 256 + col] = v; else p.out[O_VP + (size_t)(b * 128 + w) * 256 + (col - 256)] = v;
    }
    for (int i = gt; i < 2 * 3 * 2048; i += NT) {
        const int ch = i & 2047, t = (i >> 11) % 3, b = i / 6144;
        p.out[O_CONVP + i] = bf2f(WSP(bf16, WS_PROJ)[(size_t)(b * SEQ + SEQ - 3 + t) * LDP + C_X + ch]);
    }
    }
    xcd_barrier(xbar);
    if (PHMASK & 8) { const Ctx F = mk_ctx(); scan_phase(p, F); for (int it = blockIdx.x; it < 256; it += G) s2_unit(p, F, it, lds); }
    xcd_barrier(xbar);
    if (PHMASK & 16) { const Ctx F = mk_ctx(); for (int it = blockIdx.x; it < 512; it += G) ssdy_unit(p, F, it, lds); }
    { const Ctx F = mk_ctx(); for (int it = blockIdx.x; it < 704; it += G) s3_unit(p, F, it, lds); }
    xcd_barrier(xbar);
    if (PHMASK & 32) { pg8::EpiRes<false> E{nullptr, WSP(bf16, WS_U), WSP(float, WS_SS1)}; run_gemm(lds3, WSP(bf16, WS_MIX), WSP(bf16, WS_WO), 16384, 2048, 2048, E); }
    { const Ctx F = mk_ctx(); for (int it = blockIdx.x; it < 256; it += G) s4_unit(p, F, it, lds); }
    xcd_barrier(xbar);
    if (PHMASK & 64) { pg8::EpiGateUp E{WSP(bf16, WS_PROJ), WSP(float, WS_SS1)}; run_gemm<8>(lds3, WSP(bf16, WS_U), WSP(bf16, WS_WGU), 16384, 2 * FF, 2048, E); }
    xcd_barrier(xbar);
    if (PHMASK & 128) { pg8::EpiRes<false> E{nullptr, WSP(bf16, WS_U), WSP(float, WS_SS2)}; run_gemm(lds3, WSP(bf16, WS_PROJ), WSP(bf16, WS_WD), 16384, 2048, FF, E); }
    if (PHMASK & 0x8000) { pg8::EpiPlain E{WSP(bf16, WS_MIX)}; int Kq = 256; asm volatile("" : "+s"(Kq)); run_gemm(lds3, WSP(bf16, WS_PB), WSP(bf16, WS_WP), 16384, 2048, Kq, E); }
    { const Ctx F = mk_ctx(); for (int it = blockIdx.x; it < 256; it += G) s5_unit(p, F, it, lds); }
    xcd_barrier(xbar);
    if (PHMASK & 256) { pg8::EpiPle E{WSP(bf16, WS_U), WSP(bf16, WS_H3), WSP(bf16, WS_MIX), WSP(float, WS_SS2)}; run_gemm(lds3, WSP(bf16, WS_U), WSP(bf16, WS_WPG), 16384, 2048, 2048, E); }
    xcd_barrier(xbar);
    {
        const Ctx F = mk_ctx();
        const float* gf = p.in[25];
        for (int m = blockIdx.x * 8 + F.wid; m < MREAL; m += G * 8) {
            const u32x4* hb = (const u32x4*)(WSP(bf16, WS_H3) + (size_t)m * DM);
            f32x4* yr = (f32x4*)(p.out + O_Y + (size_t)m * DM);
            u32x4 w[4]; float s = 0.f;
#pragma unroll
            for (int j = 0; j < 4; ++j) { w[j] = hb[F.lane + 64 * j];
                const float a0 = bflo(w[j].x), a1 = bfhi(w[j].x), a2 = bflo(w[j].y), a3 = bfhi(w[j].y), a4 = bflo(w[j].z), a5 = bfhi(w[j].z), a6 = bflo(w[j].w), a7 = bfhi(w[j].w);
                s += ((a0 * a0 + a1 * a1) + (a2 * a2 + a3 * a3)) + ((a4 * a4 + a5 * a5) + (a6 * a6 + a7 * a7)); }
            const float rstd = 1.0f / sqrtf(wave_sum(s) * (1.0f / DM) + EPS);
#pragma unroll
            for (int j = 0; j < 4; ++j) { const int c8 = F.lane + 64 * j; const f32x4 g0 = ((const f32x4*)gf)[2 * c8], g1 = ((const f32x4*)gf)[2 * c8 + 1];
                yr[2 * c8] = (f32x4){bflo(w[j].x), bfhi(w[j].x), bflo(w[j].y), bfhi(w[j].y)} * rstd * g0;
                yr[2 * c8 + 1] = (f32x4){bflo(w[j].z), bfhi(w[j].z), bflo(w[j].w), bfhi(w[j].w)} * rstd * g1; }
        }
    }
    if (blockIdx.x == 0 && threadIdx.x == 0) __hip_atomic_store(readyw, DONE, __ATOMIC_RELAXED, __HIP_MEMORY_SCOPE_AGENT);
}

extern "C" void kernel_launch(void* const* d_in, const int* in_sizes, int n_in, void* d_out, int out_size, void* d_ws, size_t ws_size, hipStream_t stream) {
    static int grid = 0;
    if (grid == 0) {
        if (n_in != 26 || ws_size < WS_END) { fprintf(stderr, "kernel_launch: unexpected n_in %d / ws_size %zu (need %zu)\n", n_in, ws_size, (size_t)WS_END); grid = -1; return; }
        int dev = 0, cus = 0, per_cu = 0;
        hipGetDevice(&dev);
        hipDeviceGetAttribute(&cus, hipDeviceAttributeMultiprocessorCount, dev);
        hipFuncSetAttribute((const void*)mega_fwd, hipFuncAttributeMaxDynamicSharedMemorySize, LDS_BYTES);
        if (hipOccupancyMaxActiveBlocksPerMultiprocessor(&per_cu, (const void*)mega_fwd, 512, LDS_BYTES) != hipSuccess || per_cu < 1) per_cu = 1;
        (void)hipGetLastError();
        grid = cus * per_cu;
        if (grid > 256) grid = 256;
    }
    if (grid < 0) return;
    Params p{};
    for (int i = 0; i < 26; ++i) p.in[i] = (const float*)d_in[i];
    p.out = (float*)d_out; p.ws = (unsigned char*)d_ws;
    void* args[] = {&p};
    hipError_t e = hipLaunchCooperativeKernel((const void*)mega_fwd, dim3(grid), dim3(512), args, LDS_BYTES, stream);
    if (e != hipSuccess) fprintf(stderr, "cooperative launch failed: %s (grid %d)\n", hipGetErrorString(e), grid);
}
```

```cpp
#include <hip/hip_runtime.h>
#include <hip/hip_cooperative_groups.h>
#include <cstdio>
#include <cstdint>
namespace cg = cooperative_groups;
namespace pg8 {
#define PG8_LAS __attribute__((address_space(3)))
typedef unsigned short bf16_t;
typedef short bf16x8 __attribute__((ext_vector_type(8)));
typedef float f32x4 __attribute__((ext_vector_type(4)));
typedef unsigned u32x4 __attribute__((ext_vector_type(4)));
constexpr int BM = 256, BK = 64, HALF = 128, HTB = HALF * BK * 2  , STAGE_BYTES = 8 * HTB, NXCD = 8, WGM = 4;

__host__ __device__ __forceinline__ int lds_byte(int r, int c) { const int st = (r >> 4) * 2 + (c >> 5), rr = r & 15, cc = c & 31, ob = rr * 64 + cc * 2; return st * 1024 + (ob ^ (((ob >> 9) & 1) << 5)); }
__host__ __device__ __forceinline__ void stage_rc(int b, int& R, int& C) { const int st = b / 1024, sb = b % 1024, swz = sb ^ (((sb >> 9) & 1) << 5); R = (st >> 1) * 16 + swz / 64; C = (st & 1) * 32 + (swz % 64) / 2; }
__host__ __device__ __forceinline__ int perm32(int rho) { const int n = rho >> 4, i = rho & 15; return 8 * (i >> 2) + 4 * n + (i & 3); }

struct Unit { int pm, pn; };
struct Gemm { const bf16_t* A; const bf16_t* Bt; int M, N, K; };

struct StaticOrder {
    int nM, nN, nwg, G, c, wgm;
    __host__ __device__ void init(int M, int N, int G_, int c_, int wgm_ = WGM) { nM = M / BM; nN = N / BM; nwg = nM * nN; G = G_; c = c_; wgm = wgm_; }
    __host__ __device__ bool next(int i, Unit& u) const {
        const long L = (long)i * G + c; if (L >= nwg) return false;
        int wgid = (int)L; { const int q = nwg / NXCD, r = nwg % NXCD, xcd = wgid % NXCD, off = wgid / NXCD; wgid = (xcd < r ? xcd * (q + 1) : r * (q + 1) + (xcd - r) * q) + off; }
        const int nig = wgm * nN, gid = wgid / nig, fm = gid * wgm, gsz = (nM - fm) < wgm ? (nM - fm) : wgm;
        u.pm = fm + ((wgid % nig) % gsz); u.pn = (wgid % nig) / gsz; return true;
    }
    __device__ __forceinline__ void a_ready(const Unit&) const {}
    __device__ __forceinline__ void done(const Unit&) const {}
};

__device__ __forceinline__ unsigned cvt_pk_bf16(float lo, float hi) { unsigned r; asm volatile("v_cvt_pk_bf16_f32 %0, %1, %2" : "=v"(r) : "v"(lo), "v"(hi)); return r; }
template <class Epi, class Sched, bool ALIGN_EPI = false, bool SP2 = false>
__device__ __forceinline__ void gemm_phase(PG8_LAS unsigned char* lds, const Gemm g, const Sched& S, const Epi& E) {
    int tid0_ = threadIdx.x; asm volatile("" : "+v"(tid0_)); const int tid = tid0_, wid = __builtin_amdgcn_readfirstlane(tid >> 6), lane = tid & 63, wr = wid >> 2, wc = wid & 3, fr = lane & 15, fq = lane >> 4;
    const int K = g.K, nt = K / BK;
    unsigned voffA[2], voffB[2];
#pragma unroll
    for (int i = 0; i < 2; ++i) { int R, C; stage_rc(tid * 16 + i * 8192, R, C); const int Rb = Epi::PERM ? ((R & ~31) + perm32(R & 31)) : R;
        voffA[i] = (unsigned)(R * K + C) * 2u; voffB[i] = (unsigned)(Rb * K + C) * 2u; }
    const size_t kstep = (size_t)(BK * 2);
    const size_t hstep = (size_t)HALF * K * 2;
    const size_t tstep = 2 * hstep;
    const unsigned ldsw = (unsigned)wid * 1024u;
    const int aoff = lds_byte(wr * 64 + fr, fq * 8), boff = lds_byte(wc * 32 + fr, fq * 8);
#define PG8_SA(b, h) (((b) * 2 + (h)) * HTB)
#define PG8_SB(b, h) ((4 + (b) * 2 + (h)) * HTB)
#define PG8_STAGE(bufoff, gbase, voff) do { _Pragma("unroll") for (int _i = 0; _i < 2; ++_i) \
        __builtin_amdgcn_global_load_lds((const unsigned*)((const char*)(gbase) + (voff)[_i]), (PG8_LAS unsigned*)(lds + (bufoff) + ldsw + _i * 8192), 16, 0, 0); } while (0)
#define PG8_LDA(dst, b, h) do { _Pragma("unroll") for (int m = 0; m < 4; ++m) _Pragma("unroll") for (int k = 0; k < 2; ++k) dst[m][k] = *(const PG8_LAS bf16x8*)(lds + PG8_SA(b, h) + aoff + m * 2048 + k * 1024); } while (0)
#define PG8_LDB(dst, b, h) do { _Pragma("unroll") for (int n = 0; n < 2; ++n) _Pragma("unroll") for (int k = 0; k < 2; ++k) dst[n][k] = *(const PG8_LAS bf16x8*)(lds + PG8_SB(b, h) + boff + n * 2048 + k * 1024); } while (0)
#define PG8_MMA(ai, bj, At, Bt) do { __builtin_amdgcn_s_setprio(1); _Pragma("unroll") for (int m = 0; m < 4; ++m) _Pragma("unroll") for (int n = 0; n < 2; ++n) _Pragma("unroll") for (int k = 0; k < 2; ++k) \
        acc[ai][bj][m][n] = __builtin_amdgcn_mfma_f32_16x16x32_bf16(Bt[n][k], At[m][k], acc[ai][bj][m][n], 0, 0, 0); __builtin_amdgcn_s_setprio(0); } while (0)
#define PG8_WAIT_V(n) asm volatile("s_waitcnt vmcnt(" #n ")" ::: "memory")
#define PG8_WAIT_L(n) asm volatile("s_waitcnt lgkmcnt(" #n ")" ::: "memory")
#define PG8_BAR __builtin_amdgcn_s_barrier()
#define PG8_SCHED __builtin_amdgcn_sched_barrier(0)
    Unit cur, nxt; int ui = 0;
    if (!S.next(0, cur)) return;
    f32x4 acc[2][2][4][2];
#pragma unroll
    for (int a = 0; a < 2; ++a)
#pragma unroll
        for (int b = 0; b < 2; ++b)
#pragma unroll
            for (int m = 0; m < 4; ++m)
#pragma unroll
                for (int n = 0; n < 2; ++n) acc[a][b][m][n] = (f32x4){0.f, 0.f, 0.f, 0.f};
    bf16x8 At[4][2], B0[2][2], B1[2][2];
    const char* cA = (const char*)g.A + (size_t)cur.pm * tstep; const char* cB = (const char*)g.Bt + (size_t)cur.pn * tstep;
    S.a_ready(cur);
    if constexpr (SP2) {
        PG8_STAGE(PG8_SB(0, 0), cB, voffB); PG8_STAGE(PG8_SB(0, 1), cB + hstep, voffB); PG8_STAGE(PG8_SA(0, 0), cA, voffA); PG8_STAGE(PG8_SA(0, 1), cA + hstep, voffA);
        if (wr == 1) PG8_BAR;
        PG8_WAIT_V(2); PG8_BAR;
        PG8_STAGE(PG8_SB(1, 0), cB + kstep, voffB); PG8_STAGE(PG8_SA(1, 0), cA + kstep, voffA); PG8_STAGE(PG8_SB(1, 1), cB + hstep + kstep, voffB);
        PG8_WAIT_V(6); PG8_BAR;
    } else {
        PG8_STAGE(PG8_SB(0, 0), cB, voffB); PG8_STAGE(PG8_SA(0, 0), cA, voffA); PG8_STAGE(PG8_SB(0, 1), cB + hstep, voffB); PG8_STAGE(PG8_SA(0, 1), cA + hstep, voffA);
        if (wr == 1) PG8_BAR;
        PG8_WAIT_V(4); PG8_BAR;
        PG8_STAGE(PG8_SB(1, 0), cB + kstep, voffB); PG8_STAGE(PG8_SA(1, 0), cA + kstep, voffA); PG8_STAGE(PG8_SB(1, 1), cB + hstep + kstep, voffB);
        PG8_WAIT_V(6); PG8_BAR;
    }
    for (;;) {
        const bool has_next = S.next(ui + 1, nxt);
        const char* nA = has_next ? (const char*)g.A + (size_t)nxt.pm * tstep : cA; const char* nB = has_next ? (const char*)g.Bt + (size_t)nxt.pn * tstep : cB;
        for (int t = 0; t < nt; t += 2) {
            const bool last = (t == nt - 2);
            const char* a1 = cA + (size_t)(t + 1) * kstep;
            const char* a2 = last ? nA : cA + (size_t)(t + 2) * kstep; const char* b2 = last ? nB : cB + (size_t)(t + 2) * kstep;
            const char* a3 = a2 + kstep; const char* b3 = b2 + kstep;
            if (last && has_next) S.a_ready(nxt);
            if constexpr (SP2) {
            PG8_LDB(B0, 0, 0); PG8_LDB(B1, 0, 1); PG8_SCHED; PG8_LDA(At, 0, 0); PG8_STAGE(PG8_SA(1, 1), a1 + hstep, voffA);
            PG8_WAIT_V(8); PG8_WAIT_L(0); PG8_BAR; PG8_MMA(0, 0, At, B0); PG8_MMA(0, 1, At, B1); PG8_BAR; PG8_SCHED;
            PG8_LDA(At, 0, 1); PG8_STAGE(PG8_SB(0, 0), b2, voffB); PG8_STAGE(PG8_SB(0, 1), b2 + hstep, voffB); PG8_STAGE(PG8_SA(0, 0), a2, voffA);
            PG8_WAIT_V(8); PG8_WAIT_L(0); PG8_BAR; PG8_MMA(1, 0, At, B0); PG8_MMA(1, 1, At, B1); PG8_BAR; PG8_SCHED;
            PG8_LDB(B0, 1, 0); PG8_LDB(B1, 1, 1); PG8_SCHED; PG8_LDA(At, 1, 0); PG8_STAGE(PG8_SA(0, 1), a2 + hstep, voffA);
            PG8_WAIT_V(8); PG8_WAIT_L(0); PG8_BAR; PG8_MMA(0, 0, At, B0); PG8_MMA(0, 1, At, B1); PG8_BAR; PG8_SCHED;
            PG8_LDA(At, 1, 1); PG8_STAGE(PG8_SB(1, 0), b3, voffB); PG8_STAGE(PG8_SB(1, 1), b3 + hstep, voffB); PG8_STAGE(PG8_SA(1, 0), a3, voffA);
            PG8_WAIT_V(8); PG8_WAIT_L(0); PG8_BAR; PG8_MMA(1, 0, At, B0); PG8_MMA(1, 1, At, B1); PG8_BAR; PG8_SCHED;
            } else {
            PG8_LDB(B0, 0, 0); PG8_SCHED; PG8_LDA(At, 0, 0); PG8_STAGE(PG8_SA(1, 1), a1 + hstep, voffA);
            PG8_WAIT_L(8); PG8_BAR; PG8_WAIT_L(0); PG8_MMA(0, 0, At, B0); PG8_BAR; PG8_SCHED;
            PG8_LDB(B1, 0, 1); PG8_STAGE(PG8_SB(0, 0), b2, voffB);
            PG8_BAR; PG8_WAIT_L(0); PG8_MMA(0, 1, At, B1); PG8_BAR;
            PG8_LDA(At, 0, 1); PG8_STAGE(PG8_SA(0, 0), a2, voffA);
            PG8_BAR; PG8_WAIT_L(0); PG8_MMA(1, 0, At, B0); PG8_BAR; PG8_SCHED;
            PG8_STAGE(PG8_SB(0, 1), b2 + hstep, voffB);
            PG8_WAIT_V(6); PG8_BAR; PG8_MMA(1, 1, At, B1); PG8_BAR;
            PG8_LDB(B0, 1, 0); PG8_SCHED; PG8_LDA(At, 1, 0); PG8_STAGE(PG8_SA(0, 1), a2 + hstep, voffA);
            PG8_WAIT_L(8); PG8_BAR; PG8_WAIT_L(0); PG8_MMA(0, 0, At, B0); PG8_BAR; PG8_SCHED;
            PG8_LDB(B1, 1, 1); PG8_STAGE(PG8_SB(1, 0), b3, voffB);
            PG8_BAR; PG8_WAIT_L(0); PG8_MMA(0, 1, At, B1); PG8_BAR;
            PG8_LDA(At, 1, 1); PG8_STAGE(PG8_SA(1, 0), a3, voffA);
            PG8_BAR; PG8_WAIT_L(0); PG8_MMA(1, 0, At, B0); PG8_BAR; PG8_SCHED;
            PG8_STAGE(PG8_SB(1, 1), b3 + hstep, voffB);
            PG8_WAIT_V(6); PG8_BAR; PG8_MMA(1, 1, At, B1); PG8_BAR;
            }
        }
        if constexpr (ALIGN_EPI) { if (wr == 0) PG8_BAR; }
        if constexpr (!Epi::AFTER_DRAIN) { E(acc, cur, wr, wc, fr, fq); S.done(cur); }
        if (!has_next) break;
#pragma unroll
        for (int a = 0; a < 2; ++a)
#pragma unroll
            for (int b = 0; b < 2; ++b)
#pragma unroll
                for (int m = 0; m < 4; ++m)
#pragma unroll
                    for (int n = 0; n < 2; ++n) acc[a][b][m][n] = (f32x4){0.f, 0.f, 0.f, 0.f};
        cur = nxt; cA = nA; cB = nB; ++ui;
        if constexpr (ALIGN_EPI) { if (wr == 1) PG8_BAR; }
    }
    PG8_WAIT_V(0);
    if constexpr (!ALIGN_EPI) { if (wr == 0) PG8_BAR; }
    PG8_BAR;
    if constexpr (Epi::AFTER_DRAIN) { E.fused(acc, cur, wr, wc, fr, fq, lds, wid, lane); S.done(cur); }
#undef PG8_SA
#undef PG8_SB
#undef PG8_STAGE
#undef PG8_LDA
#undef PG8_LDB
#undef PG8_MMA
#undef PG8_WAIT_V
#undef PG8_WAIT_L
#undef PG8_BAR
#undef PG8_SCHED
}
}
constexpr int DM = 2048, SEQ = 8192, MREAL = 16512, MP = 16640;
constexpr int LDP = 4864, FF = 5632, INDIM = 4624;
constexpr int C_Q = 0, C_K = 1024, C_V = 1280, C_Z = 1536, C_X = 2560, C_DT = 4608;
constexpr float EPS = 1e-6f, LOG2E = 1.4426950408889634f;

namespace pg8 {
__device__ __forceinline__ float softplus_f(float x) { const float e = __builtin_amdgcn_exp2f(-fabsf(x) * LOG2E);
    const float l = (e < 0.03f) ? e * (1.0f - e * (0.5f - e * 0.33333333f)) : __builtin_amdgcn_logf(1.0f + e) * 0.6931471805599453f; return fmaxf(x, 0.f) + l; }
__device__ __forceinline__ float sigmoid_f(float x) { return __builtin_amdgcn_rcpf(1.0f + __builtin_amdgcn_exp2f(-x * LOG2E)); }
__device__ __forceinline__ u32x4 pack8(f32x4 v0, f32x4 v1) { u32x4 w; w.x = cvt_pk_bf16(v0[0], v0[1]); w.y = cvt_pk_bf16(v0[2], v0[3]); w.z = cvt_pk_bf16(v1[0], v1[1]); w.w = cvt_pk_bf16(v1[2], v1[3]); return w; }

struct EpiProj {
    static constexpr bool PERM = true, AFTER_DRAIN = false;
    bf16_t* O; float* dt; const float* tab; const float* dt_bias; const float* r0;
    __device__ __forceinline__ void operator()(const f32x4 (&acc)[2][2][4][2], const Unit& u, int wr, int wc, int fr, int fq) const {
        const int row0 = u.pm * BM + wr * 64 + fr;
        const bool rope = (u.pn < 5) && ((wc & 1) == 0);
        const bool dtt = (u.pn == 18) && (wc == 0);
        float rr0[2][4];
#pragma unroll
        for (int ai = 0; ai < 2; ++ai)
#pragma unroll
            for (int m = 0; m < 4; ++m) rr0[ai][m] = r0[row0 + ai * HALF + m * 16];
#pragma unroll
        for (int ai = 0; ai < 2; ++ai) {
#pragma unroll
            for (int m = 0; m < 4; ++m) {
                const int row = row0 + ai * HALF + m * 16;
                bf16_t* rowp = O + (size_t)row * LDP + u.pn * BM + wc * 32 + 8 * fq;
                const float rs0 = rr0[ai][m];
                f32x4 cs0 = {1.f, 1.f, 1.f, 1.f}, cs1 = cs0, sn0 = {0.f, 0.f, 0.f, 0.f}, sn1 = sn0;
                if (rope) { const int pos = row < 16384 ? (row & 8191) : 8192; const float* t = tab + (size_t)pos * 16;
                    cs0 = *(const f32x4*)t; cs1 = *(const f32x4*)(t + 4); sn0 = *(const f32x4*)(t + 8); sn1 = *(const f32x4*)(t + 12); }
#pragma unroll
                for (int bj = 0; bj < 2; ++bj) {
                    f32x4 v0 = acc[ai][bj][m][0] * rs0, v1 = acc[ai][bj][m][1] * rs0;
                    if (rope) {
                        f32x4 o0, o1;
#pragma unroll
                        for (int j = 0; j < 4; ++j) { o0[j] = __shfl_xor(v0[j], 16); o1[j] = __shfl_xor(v1[j], 16); }
                        if (fq == 0) { v0 = v0 * cs0 - o0 * sn0; v1 = v1 * cs1 - o1 * sn1; }
                        else if (fq == 1) { v0 = v0 * cs0 + o0 * sn0; v1 = v1 * cs1 + o1 * sn1; }
                    }
                    *(u32x4*)(rowp + bj * HALF) = pack8(v0, v1);
                    if (dtt && bj == 0 && fq < 2) {
                        float* dp = dt + (size_t)row * 16 + 8 * fq; const float* bb = dt_bias + 8 * fq;
                        f32x4 a, b;
#pragma unroll
                        for (int j = 0; j < 4; ++j) { a[j] = softplus_f(v0[j] + bb[j]); b[j] = softplus_f(v1[j] + bb[4 + j]); }
                        *(f32x4*)dp = a; *(f32x4*)(dp + 4) = b;
                    }
                }
                asm volatile("" ::: "memory");
            }
        }
    }
};
struct EpiPlain {
    static constexpr bool PERM = true, AFTER_DRAIN = false;
    bf16_t* O;
    __device__ __forceinline__ void operator()(const f32x4 (&acc)[2][2][4][2], const Unit& u, int wr, int wc, int fr, int fq) const {
        const int row0 = u.pm * BM + wr * 64 + fr;
#pragma unroll
        for (int ai = 0; ai < 2; ++ai)
#pragma unroll
            for (int m = 0; m < 4; ++m) {
                bf16_t* rowp = O + (size_t)(row0 + ai * HALF + m * 16) * DM + u.pn * BM + wc * 32 + 8 * fq;
#pragma unroll
                for (int bj = 0; bj < 2; ++bj) *(u32x4*)(rowp + bj * HALF) = pack8(acc[ai][bj][m][0], acc[ai][bj][m][1]);
            }
    }
};
template <bool XBASE> struct EpiRes {
    static constexpr bool PERM = true, AFTER_DRAIN = false;
    const float* X; bf16_t* HB; float* ss;
    __device__ __forceinline__ void operator()(const f32x4 (&acc)[2][2][4][2], const Unit& u, int wr, int wc, int fr, int fq) const {
        const int row0 = u.pm * BM + wr * 64 + fr;
        const size_t off0 = (size_t)row0 * DM + u.pn * BM + wc * 32 + 8 * fq;
#pragma unroll
        for (int ai = 0; ai < 2; ++ai) {
            u32x4 hb[4][2];
            if (!XBASE) {
#pragma unroll
                for (int m = 0; m < 4; ++m)
#pragma unroll
                    for (int bj = 0; bj < 2; ++bj) hb[m][bj] = *(const u32x4*)(HB + off0 + (size_t)(ai * HALF + m * 16) * DM + bj * HALF);
            }
#pragma unroll
            for (int m = 0; m < 4; ++m) {
                const int row = row0 + ai * HALF + m * 16;
                const size_t off = off0 + (size_t)(ai * HALF + m * 16) * DM;
                float sq = 0.f;
#pragma unroll
                for (int bj = 0; bj < 2; ++bj) {
                    f32x4 b0, b1;
                    if (XBASE) { b0 = *(const f32x4*)(X + off + bj * HALF); b1 = *(const f32x4*)(X + off + bj * HALF + 4); }
                    else { const u32x4 h = hb[m][bj];
                        b0 = (f32x4){__uint_as_float(h.x << 16), __uint_as_float(h.x & 0xffff0000u), __uint_as_float(h.y << 16), __uint_as_float(h.y & 0xffff0000u)};
                        b1 = (f32x4){__uint_as_float(h.z << 16), __uint_as_float(h.z & 0xffff0000u), __uint_as_float(h.w << 16), __uint_as_float(h.w & 0xffff0000u)}; }
                    const f32x4 v0 = b0 + acc[ai][bj][m][0], v1 = b1 + acc[ai][bj][m][1];
                    *(u32x4*)(HB + off + bj * HALF) = pack8(v0, v1);
                    sq += (v0[0] * v0[0] + v0[1] * v0[1]) + (v0[2] * v0[2] + v0[3] * v0[3]) + (v1[0] * v1[0] + v1[1] * v1[1]) + (v1[2] * v1[2] + v1[3] * v1[3]);
                }
                sq += __shfl_xor(sq, 16); sq += __shfl_xor(sq, 32);
                if (fq == 0) atomicAdd(ss + row, sq);
            }
            asm volatile("" ::: "memory");
        }
    }
};
struct EpiGateUp {
    static constexpr bool PERM = true, AFTER_DRAIN = false;
    bf16_t* O; const float* ss;
    __device__ __forceinline__ void operator()(const f32x4 (&acc)[2][2][4][2], const Unit& u, int wr, int wc, int fr, int fq) const {
        const int row0 = u.pm * BM + wr * 64 + fr;
        float rr[2][4];
#pragma unroll
        for (int ai = 0; ai < 2; ++ai)
#pragma unroll
            for (int m = 0; m < 4; ++m) rr[ai][m] = ss[row0 + ai * HALF + m * 16];
#pragma unroll
        for (int ai = 0; ai < 2; ++ai)
#pragma unroll
            for (int m = 0; m < 4; ++m) {
                const int row = row0 + ai * HALF + m * 16;
                const float r = 1.0f / sqrtf(rr[ai][m] * (1.0f / DM) + EPS);
                f32x4 h0, h1;
#pragma unroll
                for (int j = 0; j < 4; ++j) {
                    const float g0 = acc[ai][0][m][0][j] * r, g1 = acc[ai][0][m][1][j] * r;
                    h0[j] = g0 * sigmoid_f(g0) * (acc[ai][1][m][0][j] * r); h1[j] = g1 * sigmoid_f(g1) * (acc[ai][1][m][1][j] * r);
                }
                *(u32x4*)(O + (size_t)row * FF + u.pn * HALF + wc * 32 + 8 * fq) = pack8(h0, h1);
            }
    }
};
struct EpiPle {
    static constexpr bool PERM = true, AFTER_DRAIN = false;
    const bf16_t* HB; bf16_t* H3; const bf16_t* PE; const float* ss;
    __device__ __forceinline__ void operator()(const f32x4 (&acc)[2][2][4][2], const Unit& u, int wr, int wc, int fr, int fq) const {
        const int row0 = u.pm * BM + wr * 64 + fr;
        const size_t off0 = (size_t)row0 * DM + u.pn * BM + wc * 32 + 8 * fq;
        float rr[2][4];
#pragma unroll
        for (int ai = 0; ai < 2; ++ai)
#pragma unroll
            for (int m = 0; m < 4; ++m) rr[ai][m] = ss[row0 + ai * HALF + m * 16];
#pragma unroll
        for (int ai = 0; ai < 2; ++ai) {
            u32x4 hbv[4][2], pev[4][2];
#pragma unroll
            for (int m = 0; m < 4; ++m)
#pragma unroll
                for (int bj = 0; bj < 2; ++bj) { const size_t off = off0 + (size_t)(ai * HALF + m * 16) * DM + bj * HALF; hbv[m][bj] = *(const u32x4*)(HB + off); pev[m][bj] = *(const u32x4*)(PE + off); }
#pragma unroll
            for (int m = 0; m < 4; ++m) {
                const float r = 1.0f / sqrtf(rr[ai][m] * (1.0f / DM) + EPS);
#pragma unroll
                for (int bj = 0; bj < 2; ++bj) {
                    const size_t off = off0 + (size_t)(ai * HALF + m * 16) * DM + bj * HALF;
                    const u32x4 pe = pev[m][bj], hb = hbv[m][bj];
                    const f32x4 a0 = acc[ai][bj][m][0] * r, a1 = acc[ai][bj][m][1] * r;
                    f32x4 h0, h1;
                    h0[0] = __uint_as_float(hb.x << 16) + __uint_as_float(pe.x << 16) * sigmoid_f(a0[0]); h0[1] = __uint_as_float(hb.x & 0xffff0000u) + __uint_as_float(pe.x & 0xffff0000u) * sigmoid_f(a0[1]);
                    h0[2] = __uint_as_float(hb.y << 16) + __uint_as_float(pe.y << 16) * sigmoid_f(a0[2]); h0[3] = __uint_as_float(hb.y & 0xffff0000u) + __uint_as_float(pe.y & 0xffff0000u) * sigmoid_f(a0[3]);
                    h1[0] = __uint_as_float(hb.z << 16) + __uint_as_float(pe.z << 16) * sigmoid_f(a1[0]); h1[1] = __uint_as_float(hb.z & 0xffff0000u) + __uint_as_float(pe.z & 0xffff0000u) * sigmoid_f(a1[1]);
                    h1[2] = __uint_as_float(hb.w << 16) + __uint_as_float(pe.w << 16) * sigmoid_f(a1[2]); h1[3] = __uint_as_float(hb.w & 0xffff0000u) + __uint_as_float(pe.w & 0xffff0000u) * sigmoid_f(a1[3]);
                    *(u32x4*)(H3 + off) = pack8(h0, h1);
                }
            }
            asm volatile("" ::: "memory");
        }
    }
};
}
#define LAS __attribute__((address_space(3)))
#define XB_TMO      128
#define XB_XCNT(j)  (256  + 64 * (j))
#define XB_XSUB(j)  (1280 + 64 * (j))
#define XB_XGEN(j)  (2304 + 64 * (j))
#define XB_TOP      3328
#define XB_TOPGEN   3392
#define XCD_BAR_WORDS 3456
#define XB_SPIN_CAP (1u << 18)

__device__ __forceinline__ unsigned xb_ld(unsigned* p)              { return __hip_atomic_load(p, __ATOMIC_RELAXED, __HIP_MEMORY_SCOPE_AGENT); }
__device__ __forceinline__ unsigned xb_add(unsigned* p, unsigned v) { return __hip_atomic_fetch_add(p, v, __ATOMIC_RELAXED, __HIP_MEMORY_SCOPE_AGENT); }
__device__ __forceinline__ unsigned xb_xcc_id() { return (unsigned)__builtin_amdgcn_s_getreg((3 << 11) | 20) & 0xFu; }
#define XB_SPIN(cond, bar) do { unsigned _sp = 0; while (cond) { __builtin_amdgcn_s_sleep(1); \
    if ((++_sp & 255u) == 0u) { if (xb_ld(&(bar)[XB_TMO])) break; if (_sp > XB_SPIN_CAP) { atomicAdd(&(bar)[XB_TMO], 1u); break; } } } } while (0)

struct XcdBarrier {
    unsigned* bar; unsigned x;
    volatile LAS unsigned* st;
};

__device__ __forceinline__ XcdBarrier xcd_barrier_post(unsigned* bar, volatile LAS unsigned* st) {
    XcdBarrier b; b.bar = bar; b.x = xb_xcc_id(); b.st = st;
    if (threadIdx.x == 0) (void)xb_add(&bar[XB_XCNT(b.x)], 1u);
    return b;
}
__device__ __forceinline__ void xcd_barrier_complete(unsigned* bar, unsigned x, unsigned& nloc, unsigned& nx) {
    const unsigned G = gridDim.x * gridDim.y * gridDim.z;
    unsigned sum, cnt, mine, sp = 0u;
    for (;;) {
        sum = 0u; cnt = 0u; mine = 0u;
#pragma unroll
        for (unsigned j = 0; j < 16; ++j) { const unsigned c = xb_ld(&bar[XB_XCNT(j)]); sum += c; cnt += (c > 0u) ? 1u : 0u; mine = (j == x) ? c : mine; }
        if (sum == G) break;
        __builtin_amdgcn_s_sleep(1);
        if ((++sp & 255u) == 0u) { if (xb_ld(&bar[XB_TMO])) break; if (sp > XB_SPIN_CAP) { atomicAdd(&bar[XB_TMO], 1u); break; } }
    }
    nloc = mine > 0u ? mine : 1u; nx = cnt > 0u ? cnt : 1u;
}

__device__ __forceinline__ void xcd_barrier(const XcdBarrier& b) {
    asm volatile("s_waitcnt vmcnt(0)" ::: "memory");
    __syncthreads();
    if (threadIdx.x == 0) {
        unsigned* bar = b.bar;
        __builtin_amdgcn_s_waitcnt(0);
        unsigned nloc = b.st[0], nx = b.st[1];
        if (nloc == 0u) { xcd_barrier_complete(bar, b.x, nloc, nx); b.st[0] = nloc; b.st[1] = nx; }
        const unsigned old = xb_add(&bar[XB_XSUB(b.x)], 1u);
        const unsigned gen = old / nloc;
        if (old + 1u == (gen + 1u) * nloc) {
            __builtin_amdgcn_fence(__ATOMIC_RELEASE, "agent");
            asm volatile("s_waitcnt vmcnt(0)" ::: "memory");
            const unsigned og = xb_add(&bar[XB_TOP], 1u);
            const unsigned tg = og / nx;
            if (og + 1u == (tg + 1u) * nx) xb_add(&bar[XB_TOPGEN], 1u);
            else XB_SPIN(xb_ld(&bar[XB_TOPGEN]) == tg, bar);
            __builtin_amdgcn_fence(__ATOMIC_ACQUIRE, "agent");
            xb_add(&bar[XB_XGEN(b.x)], 1u);
            asm volatile("s_waitcnt vmcnt(0)" ::: "memory");
        } else {
            XB_SPIN(xb_ld(&bar[XB_XGEN(b.x)]) == gen, bar);
            __builtin_amdgcn_fence(__ATOMIC_ACQUIRE, "agent");
            asm volatile("s_waitcnt vmcnt(0)" ::: "memory");
        }
    }
    __syncthreads();
}
typedef unsigned short bf16;
typedef short bf16x8 __attribute__((ext_vector_type(8)));
typedef float f32x4 __attribute__((ext_vector_type(4)));
typedef float f32x2 __attribute__((ext_vector_type(2)));
typedef float f32x16 __attribute__((ext_vector_type(16)));
typedef unsigned u32x4 __attribute__((ext_vector_type(4)));
typedef unsigned u32x2 __attribute__((ext_vector_type(2)));

constexpr size_t MiB = 1u << 20;
constexpr size_t WS_WIN = 0 * MiB;
constexpr size_t WS_WO = 19 * MiB;
constexpr size_t WS_WGU = 27 * MiB;
constexpr size_t WS_WD = 71 * MiB;
constexpr size_t WS_WP = 93 * MiB;
constexpr size_t WS_WPG = 94 * MiB;
constexpr size_t WS_DT = 102 * MiB;
constexpr size_t WS_TAB = 104 * MiB;
constexpr size_t WS_SS1 = 105 * MiB;
constexpr size_t WS_SS2 = 105 * MiB + 128 * 1024;
constexpr size_t WS_R0 = 105 * MiB + 640 * 1024;
constexpr size_t WS_DEC = 105 * MiB + 256 * 1024;
constexpr size_t WS_BAR = 105 * MiB + 512 * 1024;
constexpr size_t WS_PB = 106 * MiB;
constexpr size_t WS_U = 115 * MiB;
constexpr size_t WS_MIX = 180 * MiB;
constexpr size_t WS_PROJ = 245 * MiB;
constexpr size_t WS_END = 424 * MiB;
constexpr size_t WS_H3 = 0;
constexpr size_t O_Y = 0, O_KP = 33816576, O_VP = 33882112, O_SSMP = 33947648, O_CONVP = 34209792, O_KS = 34222080, O_VS = 38416384, O_SSMS = 42610688, O_CONVS = 59387904;
constexpr size_t OS_STATES = 0;
constexpr size_t OS_PREV = 16777216;

struct Params { const float* in[26]; float* out; unsigned char* ws; };

typedef __bf16 bf16x2_t __attribute__((ext_vector_type(2)));
__device__ __forceinline__ unsigned pk2(float lo, float hi) { f32x2 v = {lo, hi}; bf16x2_t b = __builtin_convertvector(v, bf16x2_t); return __builtin_bit_cast(unsigned, b); }
__device__ __forceinline__ unsigned f2bf(float f) { return pk2(f, 0.f) & 0xffffu; }
__device__ __forceinline__ float bf2f(bf16 b) { return __uint_as_float(((unsigned)b) << 16); }
__device__ __forceinline__ float bflo(unsigned w) { return __uint_as_float(w << 16); }
__device__ __forceinline__ float bfhi(unsigned w) { return __uint_as_float(w & 0xffff0000u); }
__device__ __forceinline__ int crow(int r, int hi) { return (r & 3) + 8 * (r >> 2) + 4 * hi; }
__device__ __forceinline__ float wave_sum(float v) {
#pragma unroll
    for (int o = 1; o < 64; o <<= 1) v += __shfl_xor(v, o);
    return v;
}
__device__ __forceinline__ float wave_max(float v) {
#pragma unroll
    for (int o = 1; o < 64; o <<= 1) v = fmaxf(v, __shfl_xor(v, o));
    return v;
}
__device__ __forceinline__ float fexp(float x) { return __builtin_amdgcn_exp2f(x * LOG2E); }
__device__ __forceinline__ float silu_f(float x) { return x * __builtin_amdgcn_rcpf(1.0f + __builtin_amdgcn_exp2f(-x * LOG2E)); }
#define MFMA32(a, b, c) __builtin_amdgcn_mfma_f32_32x32x16_bf16((a), (b), (c), 0, 0, 0)
#define LDSW() asm volatile("s_waitcnt lgkmcnt(0)" ::: "memory")

struct Ctx { int tid, lane, wid; };
#define WSP(T, off) ((T*)(p.ws + (off)))
__device__ __forceinline__ Ctx mk_ctx() { int t = threadIdx.x; asm volatile("" : "+v"(t)); Ctx F; F.tid = t; F.lane = t & 63; F.wid = __builtin_amdgcn_readfirstlane(t >> 6); return F; }

__device__ __forceinline__ void p0_transpose_item(const float* W, int K, int N, bf16* WT, float* scr, int item, int lane, const float* gk, int mode, int nblk) {
    const int kb = item / nblk, nb = item % nblk, k0 = 64 * kb, n0 = 32 * nb;
    const int kr = lane >> 3, n4 = (lane & 7) * 4; const bool ok = (n0 + n4) < N;
#pragma unroll
    for (int i = 0; i < 8; ++i) { const int kk = kr + 8 * i; f32x4 v = {0.f, 0.f, 0.f, 0.f};
        if (ok) v = __builtin_nontemporal_load((const f32x4*)(W + (size_t)(k0 + kk) * N + n0 + n4));
        if (gk) v = v * gk[k0 + kk];
        float* d = scr + kk * 33 + n4; d[0] = v[0]; d[1] = v[1]; d[2] = v[2]; d[3] = v[3]; }
    LDSW();
    const int c = lane & 7;
#pragma unroll
    for (int j = 0; j < 4; ++j) { const int n = (lane >> 3) + 8 * j; const float* s = scr + (8 * c) * 33 + n;
        u32x4 o; o.x = pk2(s[0 * 33], s[1 * 33]); o.y = pk2(s[2 * 33], s[3 * 33]); o.z = pk2(s[4 * 33], s[5 * 33]); o.w = pk2(s[6 * 33], s[7 * 33]);
        const int nd = n0 + n; const int drow = (mode == 0) ? nd : ((nd >> 7) * 256 + (nd & 127) + (mode == 2 ? 128 : 0));
        *(u32x4*)(WT + (size_t)drow * K + k0 + 8 * c) = o; }
    LDSW();
}
__device__ __forceinline__ void p0_prologue(const Params& p, const Ctx& F, unsigned char* lds) {
    float* scr = (float*)(lds + F.wid * 16384);
    const int G = gridDim.x, gw = blockIdx.x * 8 + F.wid, NGW = G * 8, lane = F.lane;
    constexpr int I_IN = 32 * 152, I_O = 32 * 64, I_G = 32 * 176, I_D = 88 * 64, I_P = 4 * 64, I_PG = 32 * 64;
    constexpr int NITEMS = I_IN + I_O + 2 * I_G + I_D + I_P + I_PG;
    for (int it = gw; it < NITEMS; it += NGW) {
        int r = it;
        if (r < I_IN) { p0_transpose_item(p.in[8], 2048, INDIM, WSP(bf16, WS_WIN), scr, r, lane, p.in[17], 0, 152); continue; } r -= I_IN;
        if (r < I_O) { p0_transpose_item(p.in[16], 2048, 2048, WSP(bf16, WS_WO), scr, r, lane, nullptr, 0, 64); continue; } r -= I_O;
        if (r < I_G) { p0_transpose_item(p.in[19], 2048, FF, WSP(bf16, WS_WGU), scr, r, lane, p.in[18], 1, 176); continue; } r -= I_G;
        if (r < I_G) { p0_transpose_item(p.in[20], 2048, FF, WSP(bf16, WS_WGU), scr, r, lane, p.in[18], 2, 176); continue; } r -= I_G;
        if (r < I_D) { p0_transpose_item(p.in[21], FF, 2048, WSP(bf16, WS_WD), scr, r, lane, nullptr, 0, 64); continue; } r -= I_D;
        if (r < I_P) { p0_transpose_item(p.in[23], 256, 2048, WSP(bf16, WS_WP), scr, r, lane, nullptr, 0, 64); continue; } r -= I_P;
        p0_transpose_item(p.in[24], 2048, 2048, WSP(bf16, WS_WPG), scr, r, lane, p.in[22], 0, 64);
    }
    const float* gm = p.in[17];
    for (int m = gw; m < MP; m += NGW) {
        unsigned long long* o8 = (unsigned long long*)(WSP(bf16, WS_U) + (size_t)m * DM) + lane;
        unsigned long long* p8 = (unsigned long long*)(WSP(bf16, WS_PB) + (size_t)m * 256) + lane;
        if (m >= MREAL) {
#pragma unroll
            for (int j = 0; j < 8; ++j) o8[64 * j] = 0ull;
            p8[0] = 0ull; continue;
        }
        const float* xr = (m < 16384) ? p.in[0] + (size_t)m * DM : p.in[1] + (size_t)(m - 16384) * DM;
        const float* pr = (m < 16384) ? p.in[6] + (size_t)m * 256 : p.in[7] + (size_t)(m - 16384) * 256;
        f32x4 v[8]; float s = 0.f;
#pragma unroll
        for (int j = 0; j < 8; ++j) { v[j] = __builtin_nontemporal_load((const f32x4*)xr + lane + 64 * j); s += (v[j][0] * v[j][0] + v[j][1] * v[j][1]) + (v[j][2] * v[j][2] + v[j][3] * v[j][3]); }
        const float rstd = 1.0f / sqrtf(wave_sum(s) * (1.0f / DM) + EPS);
        if (lane == 0) WSP(float, WS_R0)[m] = rstd;
#pragma unroll
        for (int j = 0; j < 8; ++j) o8[64 * j] = (unsigned long long)pk2(v[j][0], v[j][1]) | ((unsigned long long)pk2(v[j][2], v[j][3]) << 32);
        const f32x4 pv = ((const f32x4*)pr)[lane];
        p8[0] = (unsigned long long)pk2(pv[0], pv[1]) | ((unsigned long long)pk2(pv[2], pv[3]) << 32);
    }
    const int gt = blockIdx.x * 512 + F.tid, NT = G * 512;
    for (int pi = gt; pi < 8193; pi += NT) {
        const double pos = (pi < 8192) ? (double)pi : 16384.0;
        const double INV[8] = {1.0, 0.19392274474868576, 0.03760603093086393, 0.007292664737217109, 0.001414213562373095, 0.0002742481756762073, 5.318295896944988e-05, 1.031338537721246e-05};
#pragma unroll
        for (int i = 0; i < 8; ++i) { double rev = pos * INV[i] * 0.15915494309189535; rev -= __builtin_rint(rev); const float rf = (float)rev;
            WSP(float, WS_TAB)[(size_t)pi * 16 + i] = __builtin_amdgcn_cosf(rf); WSP(float, WS_TAB)[(size_t)pi * 16 + 8 + i] = __builtin_amdgcn_sinf(rf); }
    }
    for (int i = gt; i < MP; i += NT) { WSP(float, WS_SS1)[i] = 0.f; WSP(float, WS_SS2)[i] = 0.f; }
}

__device__ __forceinline__ void conv8(const Params& p, const Ctx& F, long tok, int tpos, int ch, float (&out)[8]) {
    const float* cw = p.in[9]; const float* cb = p.in[10];
    const f32x4 b0 = *(const f32x4*)(cb + ch), b1 = *(const f32x4*)(cb + ch + 4);
    float a[8] = {b0[0], b0[1], b0[2], b0[3], b1[0], b1[1], b1[2], b1[3]};
#pragma unroll
    for (int t = 0; t < 4; ++t) {
        if (tpos - 3 + t >= 0) {
            const u32x4 raw = *(const u32x4*)(WSP(bf16, WS_PROJ) + (size_t)(tok - 3 + t) * LDP + C_X + ch);
            const f32x4 w0 = *(const f32x4*)(cw + t * 2048 + ch), w1 = *(const f32x4*)(cw + t * 2048 + ch + 4);
            a[0] += w0[0] * bflo(raw.x); a[1] += w0[1] * bfhi(raw.x); a[2] += w0[2] * bflo(raw.y); a[3] += w0[3] * bfhi(raw.y);
            a[4] += w1[0] * bflo(raw.z); a[5] += w1[1] * bfhi(raw.z); a[6] += w1[2] * bflo(raw.w); a[7] += w1[3] * bfhi(raw.w);
        }
    }
#pragma unroll
    for (int i = 0; i < 8; ++i) out[i] = silu_f(a[i]);
}


__device__ __forceinline__ void conv4x4(const Params& p, long tokc, int c, int j0, int ch, float (&o)[4][4]) {
    const float* cw = p.in[9]; const float* cb = p.in[10];
    u32x2 raw[7];
#pragma unroll
    for (int t = 0; t < 7; ++t) { raw[t] = (u32x2){0u, 0u};
        if (c * 128 + j0 - 3 + t >= 0) raw[t] = *(const u32x2*)(WSP(bf16, WS_PROJ) + (size_t)(tokc + j0 - 3 + t) * LDP + C_X + ch); }
    f32x4 w[4];
#pragma unroll
    for (int t = 0; t < 4; ++t) w[t] = *(const f32x4*)(cw + t * 2048 + ch);
    const f32x4 b0 = *(const f32x4*)(cb + ch);
#pragma unroll
    for (int q = 0; q < 4; ++q) {
        f32x4 a0 = b0;
#pragma unroll
        for (int t = 0; t < 4; ++t) { const u32x2 r = raw[q + t]; a0 = a0 + w[t] * (f32x4){bflo(r.x), bfhi(r.x), bflo(r.y), bfhi(r.y)}; }
#pragma unroll
        for (int i = 0; i < 4; ++i) o[q][i] = silu_f(a0[i]);
    }
}
__device__ __forceinline__ void store_t4(bf16* T, int row0, int tg, const float (&o)[4][4], float s0, float s1, float s2, float s3) {
    const int qp = tg ^ ((row0 >> 3) & 15);
#pragma unroll
    for (int i = 0; i < 4; ++i) { u32x2 w; w.x = pk2(o[0][i] * s0, o[1][i] * s1); w.y = pk2(o[2][i] * s2, o[3][i] * s3);
        *(u32x2*)(T + (row0 + i) * 136 + 4 * qp) = w; }
}
__device__ __forceinline__ bf16x8 load_t8(const bf16* T, int row, int ks, int hi) {
    const int sw = (row >> 3) & 15, qa = 4 * ks + 2 * hi;
    const u32x2 lo = *(const u32x2*)(T + row * 136 + 4 * (qa ^ sw)), h2 = *(const u32x2*)(T + row * 136 + 4 * ((qa + 1) ^ sw));
    const u32x4 w = {lo.x, lo.y, h2.x, h2.y};
    return __builtin_bit_cast(bf16x8, w);
}

__device__ __forceinline__ void attn_unit(const Params& p, const Ctx& F, int unit, unsigned char* lds) {
    const int tid = F.tid, lane = F.lane, wid = F.wid, l31 = lane & 31, hi = lane >> 5;
    const int kvh = unit & 3, blk = (unit >> 2) & 63, b = unit >> 8;
    bf16* Ks = (bf16*)lds;
    bf16* Vt = (bf16*)(lds + 36864);
    const bf16* proj = WSP(bf16, WS_PROJ);
    const long tok0 = (long)b * SEQ + (long)(blk - 1) * 128;
    u32x4 kvs[4], vvs[4];
#pragma unroll
    for (int it = 0; it < 4; ++it) {
        const int id = tid + it * 512, row = id >> 3, ch = id & 7;
        const bool ok = (blk > 0) || (row >= 128);
        kvs[it] = (u32x4){0u, 0u, 0u, 0u}; vvs[it] = (u32x4){0u, 0u, 0u, 0u};
        if (ok) { const bf16* src = proj + (size_t)(tok0 + row) * LDP; kvs[it] = *(const u32x4*)(src + C_K + kvh * 64 + ch * 8); vvs[it] = *(const u32x4*)(src + C_V + kvh * 64 + ch * 8); }
    }
#pragma unroll
    for (int it = 0; it < 4; ++it) {
        const int id = tid + it * 512, row = id >> 3, ch = id & 7;
        const u32x4 kv = kvs[it], vv = vvs[it];
        *(u32x4*)(Ks + row * 72 + ch * 8) = kv;
        bf16* vt = Vt + (ch * 8) * 260 + row;
        vt[0 * 260] = (bf16)(vv.x & 0xffffu); vt[1 * 260] = (bf16)(vv.x >> 16); vt[2 * 260] = (bf16)(vv.y & 0xffffu); vt[3 * 260] = (bf16)(vv.y >> 16);
        vt[4 * 260] = (bf16)(vv.z & 0xffffu); vt[5 * 260] = (bf16)(vv.z >> 16); vt[6 * 260] = (bf16)(vv.w & 0xffffu); vt[7 * 260] = (bf16)(vv.w >> 16);
    }
    __syncthreads();
    const int rh = wid >> 1, hq = wid & 1, h = kvh * 4 + rh;
    const float sink2 = p.in[15][h] * LOG2E, SC = 0.125f * LOG2E, NEG = -INFINITY;
    bf16x8 qall[2][4];
#pragma unroll
    for (int sb = 0; sb < 2; ++sb)
#pragma unroll
        for (int ks = 0; ks < 4; ++ks) qall[sb][ks] = *(const bf16x8*)(proj + (size_t)((long)b * SEQ + blk * 128 + hq * 64 + sb * 32 + l31) * LDP + C_Q + h * 64 + ks * 16 + hi * 8);
#pragma unroll 1
    for (int sb = 0; sb < 2; ++sb) {
        const int i0 = hq * 64 + sb * 32, jb0 = i0 >> 5;
        const long qtok = (long)b * SEQ + blk * 128 + i0 + l31;
        bf16x8 qf[4];
#pragma unroll
        for (int ks = 0; ks < 4; ++ks) qf[ks] = sb ? qall[1][ks] : qall[0][ks];
        f32x16 S[5];
#pragma unroll
        for (int jbi = 0; jbi < 5; ++jbi) {
            f32x16 a = {0.f, 0.f, 0.f, 0.f, 0.f, 0.f, 0.f, 0.f, 0.f, 0.f, 0.f, 0.f, 0.f, 0.f, 0.f, 0.f};
#pragma unroll
            for (int ks = 0; ks < 4; ++ks) { const bf16x8 kf = *(const bf16x8*)(Ks + (32 * (jb0 + jbi) + l31) * 72 + ks * 16 + hi * 8); a = MFMA32(kf, qf[ks], a); }
            S[jbi] = a;
        }
        float mx = NEG;
        if (blk > 0) {
#pragma unroll
            for (int r = 0; r < 16; ++r) { const int jj = crow(r, hi);
                S[0][r] = (jj > l31) ? S[0][r] : NEG; S[4][r] = (jj <= l31) ? S[4][r] : NEG; }
        } else {
            const int i = i0 + l31;
#pragma unroll
            for (int jbi = 0; jbi < 5; ++jbi)
#pragma unroll
                for (int r = 0; r < 16; ++r) { const int j = 32 * (jb0 + jbi) + crow(r, hi);
                    const bool valid = (j > i) && (j <= i + 128) && (j >= 128);
                    S[jbi][r] = valid ? S[jbi][r] : NEG; }
        }
#pragma unroll
        for (int jbi = 0; jbi < 5; ++jbi)
#pragma unroll
            for (int r = 0; r < 16; ++r) mx = fmaxf(mx, S[jbi][r]);
        mx = fmaxf(mx, __shfl_xor(mx, 32)); mx = fmaxf(mx * SC, sink2);
        float sum = 0.f;
#pragma unroll
        for (int jbi = 0; jbi < 5; ++jbi)
#pragma unroll
            for (int r = 0; r < 16; ++r) { const float e = __builtin_amdgcn_exp2f(__builtin_fmaf(S[jbi][r], SC, -mx)); S[jbi][r] = e; sum += e; }
        sum += __shfl_xor(sum, 32); sum += __builtin_amdgcn_exp2f(sink2 - mx);
        const float inv = 1.0f / sum;
        f32x16 o[2];
        o[0] = (f32x16){0.f, 0.f, 0.f, 0.f, 0.f, 0.f, 0.f, 0.f, 0.f, 0.f, 0.f, 0.f, 0.f, 0.f, 0.f, 0.f}; o[1] = o[0];
#pragma unroll
        for (int jbi = 0; jbi < 5; ++jbi)
#pragma unroll
            for (int s = 0; s < 2; ++s) {
                u32x4 pw; pw.x = pk2(S[jbi][8 * s + 0], S[jbi][8 * s + 1]); pw.y = pk2(S[jbi][8 * s + 2], S[jbi][8 * s + 3]); pw.z = pk2(S[jbi][8 * s + 4], S[jbi][8 * s + 5]); pw.w = pk2(S[jbi][8 * s + 6], S[jbi][8 * s + 7]);
                const bf16x8 pf = __builtin_bit_cast(bf16x8, pw);
                const int kb = 32 * (jb0 + jbi) + 16 * s + 4 * hi;
#pragma unroll
                for (int db = 0; db < 2; ++db) { const bf16* vr = Vt + (32 * db + l31) * 260 + kb;
                    const u32x2 lo = *(const u32x2*)vr, hh = *(const u32x2*)(vr + 8); const u32x4 vw = {lo.x, lo.y, hh.x, hh.y};
                    o[db] = MFMA32(__builtin_bit_cast(bf16x8, vw), pf, o[db]); }
            }
        bf16* orow = WSP(bf16, WS_MIX) + (size_t)qtok * DM + h * 64;
#pragma unroll
        for (int db = 0; db < 2; ++db)
#pragma unroll
            for (int rg = 0; rg < 4; ++rg) { u32x2 w; w.x = pk2(o[db][4 * rg] * inv, o[db][4 * rg + 1] * inv); w.y = pk2(o[db][4 * rg + 2] * inv, o[db][4 * rg + 3] * inv);
                *(u32x2*)(orow + 32 * db + 8 * rg + 4 * hi) = w; }
    }
    __syncthreads();
}

__device__ __forceinline__ void chunk_cumsum(const Params& p, const Ctx& F, long tokc, int g, float* csl, float* dtl, float* decay_out) {
    if (F.wid < 4) {
        const int lane = F.lane, hh = 4 * g + F.wid; const float a = -fexp(p.in[12][hh]);
        const float d0 = WSP(float, WS_DT)[(size_t)(tokc + 2 * lane) * 16 + hh], d1 = WSP(float, WS_DT)[(size_t)(tokc + 2 * lane + 1) * 16 + hh];
        const float x0 = d0 * a, x1 = x0 + d1 * a;
        float run = x1;
#pragma unroll
        for (int off = 1; off < 64; off <<= 1) { const float t = __shfl_up(run, off); if (lane >= off) run += t; }
        const float excl = run - x1;
        csl[F.wid * 128 + 2 * lane] = excl + x0; csl[F.wid * 128 + 2 * lane + 1] = excl + x1;
        dtl[F.wid * 128 + 2 * lane] = d0; dtl[F.wid * 128 + 2 * lane + 1] = d1;
        if (decay_out && lane == 63) decay_out[hh] = fexp(run);
    }
}

__device__ __forceinline__ void state_unit(const Params& p, const Ctx& F, int unit, unsigned char* lds) {
    const int tid = F.tid, lane = F.lane, wid = F.wid, l31 = lane & 31, hi = lane >> 5;
    const int g = unit & 3, c = (unit >> 2) & 63, b = unit >> 8;
    bf16* XwT = (bf16*)lds;
    bf16* BT = (bf16*)(lds + 69632);
    float* csl = (float*)(lds + 104448);
    float* dtl = csl + 512;
    const long tokc = (long)b * SEQ + c * 128;
    chunk_cumsum(p, F, tokc, g, csl, dtl, WSP(float, WS_DEC) + (size_t)(b * 64 + c) * 16);
    __syncthreads();
#pragma unroll 1
    for (int ps = 0; ps < 4; ++ps) {
        const int chunk = tid & 63, tg = (tid >> 6) + 8 * ps, hl = chunk >> 4;
        float o[4][4];
        conv4x4(p, tokc, c, 4 * tg, 256 * g + chunk * 4, o);
        const float ce = csl[hl * 128 + 127];
        const f32x4 dv = *(const f32x4*)(dtl + hl * 128 + 4 * tg), cv = *(const f32x4*)(csl + hl * 128 + 4 * tg);
        store_t4(XwT, chunk * 4, tg, o, dv[0] * fexp(ce - cv[0]), dv[1] * fexp(ce - cv[1]), dv[2] * fexp(ce - cv[2]), dv[3] * fexp(ce - cv[3]));
    }
#pragma unroll 1
    for (int ps = 0; ps < 2; ++ps) {
        const int chunk = tid & 31, tg = (tid >> 5) + 16 * ps;
        float o[4][4];
        conv4x4(p, tokc, c, 4 * tg, 1024 + 128 * g + chunk * 4, o);
        store_t4(BT, chunk * 4, tg, o, 1.f, 1.f, 1.f, 1.f);
    }
    __syncthreads();
    const int hl = wid >> 1, pb = wid & 1;
    f32x16 acc[4];
#pragma unroll
    for (int nb = 0; nb < 4; ++nb) acc[nb] = (f32x16){0.f, 0.f, 0.f, 0.f, 0.f, 0.f, 0.f, 0.f, 0.f, 0.f, 0.f, 0.f, 0.f, 0.f, 0.f, 0.f};
#pragma unroll
    for (int ks = 0; ks < 8; ++ks) {
        const bf16x8 af = load_t8(XwT, hl * 64 + 32 * pb + l31, ks, hi);
#pragma unroll
        for (int nb = 0; nb < 4; ++nb) { const bf16x8 bf = load_t8(BT, 32 * nb + l31, ks, hi); acc[nb] = MFMA32(af, bf, acc[nb]); }
        if (ks & 1) asm volatile("" ::: "memory");
    }
    bf16* st = (bf16*)(p.out + OS_STATES) + ((size_t)((b * 64 + c) * 16 + 4 * g + hl) * 64) * 128;
    const bool odd = (l31 & 1) != 0;
#pragma unroll
    for (int nb = 0; nb < 4; ++nb)
#pragma unroll
        for (int r = 0; r < 16; r += 2) {
            const float a = acc[nb][r], b2 = acc[nb][r + 1];
            const float recv = __shfl_xor(odd ? a : b2, 1);
            const unsigned w = odd ? pk2(recv, b2) : pk2(a, recv);
            *(unsigned*)(st + (size_t)(32 * pb + crow(odd ? r + 1 : r, hi)) * 128 + 32 * nb + (l31 & ~1)) = w;
        }
    __syncthreads();
}

__device__ __forceinline__ void sample_unit(const Params& p, const Ctx& F, int b, int sp, unsigned char* lds) {
    const int tid = F.tid, lane = F.lane, wid = F.wid;
    float* qs = (float*)lds;
    float* sc = qs + 1024;
    float* xbc = sc + 2048;
    float* ys = xbc + 2048;
    float* part = ys + 1024;
    const size_t row = 16384 + b;
    const bf16* prow = WSP(bf16, WS_PROJ) + row * LDP;
    float* out = p.out;
    if (sp == 0) for (int i = tid; i < 1024; i += 512) qs[i] = bf2f(prow[C_Q + i]);
    if (sp == 1) {
        const int ch = tid * 4;
        const float* cst = p.in[5] + (size_t)b * 3 * 2048 + ch;
        const f32x4 c0 = *(const f32x4*)cst, c1 = *(const f32x4*)(cst + 2048), c2 = *(const f32x4*)(cst + 4096);
        const u32x2 raw = *(const u32x2*)(prow + C_X + ch);
        const f32x4 xin = {bflo(raw.x), bfhi(raw.x), bflo(raw.y), bfhi(raw.y)};
        const float* cw = p.in[9] + ch;
        const f32x4 w0 = *(const f32x4*)cw, w1 = *(const f32x4*)(cw + 2048), w2 = *(const f32x4*)(cw + 4096), w3 = *(const f32x4*)(cw + 6144);
        const f32x4 a = *(const f32x4*)(p.in[10] + ch) + w0 * c0 + w1 * c1 + w2 * c2 + w3 * xin;
        f32x4 o; o[0] = silu_f(a[0]); o[1] = silu_f(a[1]); o[2] = silu_f(a[2]); o[3] = silu_f(a[3]);
        *(f32x4*)(xbc + ch) = o;
        float* nc = out + O_CONVS + (size_t)b * 3 * 2048 + ch;
        *(f32x4*)nc = c1; *(f32x4*)(nc + 2048) = c2; *(f32x4*)(nc + 4096) = xin;
    }
    __syncthreads();
    if (sp == 0) {
    {
        const int kvh = tid >> 7, c = tid & 127;
        float d0 = 0.f, d1 = 0.f, d2 = 0.f, d3 = 0.f;
        float* nk = out + O_KS + (((size_t)b * 128 + c) * 4 + kvh) * 64;
        const float* qb = qs + kvh * 256;
        if (c < 127) {
            const float* kr = p.in[2] + (((size_t)b * 128 + c + 1) * 4 + kvh) * 64;
#pragma unroll 1
            for (int h8 = 0; h8 < 16; h8 += 8) {
                f32x4 kvv[8];
#pragma unroll
                for (int q = 0; q < 8; ++q) kvv[q] = ((const f32x4*)kr)[h8 + q];
#pragma unroll
                for (int q = 0; q < 8; ++q) { const int d4 = h8 + q; const f32x4 kv = kvv[q]; ((f32x4*)nk)[d4] = kv;
#pragma unroll
                    for (int j = 0; j < 4; ++j) { const float k = kv[j]; const int d = 4 * d4 + j; d0 += k * qb[d]; d1 += k * qb[64 + d]; d2 += k * qb[128 + d]; d3 += k * qb[192 + d]; } }
            }
        } else {
            const bf16* kr = prow + C_K + kvh * 64;
#pragma unroll 4
            for (int d4 = 0; d4 < 16; ++d4) { const u32x2 raw = *(const u32x2*)(kr + 4 * d4); const f32x4 kv = {bflo(raw.x), bfhi(raw.x), bflo(raw.y), bfhi(raw.y)}; ((f32x4*)nk)[d4] = kv;
#pragma unroll
                for (int j = 0; j < 4; ++j) { const float k = kv[j]; const int d = 4 * d4 + j; d0 += k * qb[d]; d1 += k * qb[64 + d]; d2 += k * qb[128 + d]; d3 += k * qb[192 + d]; } }
        }
        sc[(kvh * 4 + 0) * 128 + c] = d0 * 0.125f; sc[(kvh * 4 + 1) * 128 + c] = d1 * 0.125f; sc[(kvh * 4 + 2) * 128 + c] = d2 * 0.125f; sc[(kvh * 4 + 3) * 128 + c] = d3 * 0.125f;
    }
    __syncthreads();
#pragma unroll
    for (int hh = 0; hh < 2; ++hh) {
        const int h = 2 * wid + hh; const float s0 = sc[h * 128 + lane], s1 = sc[h * 128 + 64 + lane], sink = p.in[15][h];
        const float m = fmaxf(wave_max(fmaxf(s0, s1)), sink);
        const float e0 = fexp(s0 - m), e1 = fexp(s1 - m);
        const float inv = 1.0f / (wave_sum(e0 + e1) + fexp(sink - m));
        sc[h * 128 + lane] = e0 * inv; sc[h * 128 + 64 + lane] = e1 * inv;
    }
    __syncthreads();
    {
        const int kg = tid >> 6, kvh = (tid >> 4) & 3, d4 = tid & 15;
        f32x4 a0 = {0.f, 0.f, 0.f, 0.f}, a1 = a0, a2 = a0, a3 = a0;
#pragma unroll 1
        for (int cb = 0; cb < 16; cb += 8) {
            f32x4 vv[8];
#pragma unroll
            for (int ci = 0; ci < 8; ++ci) { const int c = kg * 16 + cb + ci;
                if (c < 127) vv[ci] = *(const f32x4*)(p.in[3] + (((size_t)b * 128 + c + 1) * 4 + kvh) * 64 + 4 * d4);
                else { const u32x2 raw = *(const u32x2*)(prow + C_V + kvh * 64 + 4 * d4); vv[ci] = (f32x4){bflo(raw.x), bfhi(raw.x), bflo(raw.y), bfhi(raw.y)}; } }
#pragma unroll
            for (int ci = 0; ci < 8; ++ci) { const int c = kg * 16 + cb + ci;
                *(f32x4*)(out + O_VS + (((size_t)b * 128 + c) * 4 + kvh) * 64 + 4 * d4) = vv[ci];
                const float* pr = sc + (kvh * 4) * 128 + c;
                a0 = a0 + vv[ci] * pr[0]; a1 = a1 + vv[ci] * pr[128]; a2 = a2 + vv[ci] * pr[256]; a3 = a3 + vv[ci] * pr[384]; }
        }
        float* pp = ys + 1024 + 16;
        float* pd = pp + (kg * 16 + kvh * 4) * 64 + 4 * d4;
        *(f32x4*)pd = a0; *(f32x4*)(pd + 64) = a1; *(f32x4*)(pd + 128) = a2; *(f32x4*)(pd + 192) = a3;
        __syncthreads();
        const int h = tid >> 5, d = 2 * (tid & 31);
        float o0 = 0.f, o1 = 0.f;
#pragma unroll
        for (int k = 0; k < 8; ++k) { const f32x2 t = *(const f32x2*)(pp + (k * 16 + h) * 64 + d); o0 += t[0]; o1 += t[1]; }
        *(unsigned*)(WSP(bf16, WS_MIX) + row * DM + h * 64 + d) = pk2(o0, o1);
    }
    } else {
    {
        const int half = lane >> 5, l4 = (lane & 31) * 4;
#pragma unroll 1
        for (int k = 0; k < 128; k += 8) {
            const int id0 = wid * 128 + k, h = id0 >> 6, g = h >> 2;
            const float dtv = WSP(float, WS_DT)[row * 16 + h], dA = fexp(-dtv * fexp(p.in[12][h])), dsk = p.in[13][h];
            const f32x4 Bn = *(const f32x4*)(xbc + 1024 + g * 128 + l4), Cn = *(const f32x4*)(xbc + 1536 + g * 128 + l4);
            f32x4 st[4];
#pragma unroll
            for (int u = 0; u < 4; ++u) { const int pp = (id0 & 63) + 2 * u + half; st[u] = *(const f32x4*)(p.in[4] + (((size_t)b * 16 + h) * 64 + pp) * 128 + l4); }
#pragma unroll
            for (int u = 0; u < 4; ++u) { const int pp = (id0 & 63) + 2 * u + half;
                const float xv = xbc[h * 64 + pp], xd = xv * dtv;
                const f32x4 nw = st[u] * dA + Bn * xd;
                *(f32x4*)(out + O_SSMS + (((size_t)b * 16 + h) * 64 + pp) * 128 + l4) = nw;
                float yp = (nw[0] * Cn[0] + nw[1] * Cn[1]) + (nw[2] * Cn[2] + nw[3] * Cn[3]);
#pragma unroll
                for (int o = 1; o < 32; o <<= 1) yp += __shfl_xor(yp, o);
                if ((lane & 31) == 0) ys[h * 64 + pp] = yp + dsk * xv; }
        }
    }
    __syncthreads();
    {
        float v[2];
#pragma unroll
        for (int q = 0; q < 2; ++q) { const int ch = tid + 512 * q; v[q] = ys[ch] * silu_f(bf2f(prow[C_Z + ch])); const float s = wave_sum(v[q] * v[q]); if (lane == 0) part[wid * 2 + q] = s; }
        __syncthreads();
        const int wb = (wid >> 2) * 4;
#pragma unroll
        for (int q = 0; q < 2; ++q) { const int ch = tid + 512 * q;
            const float tot = (part[(wb + 0) * 2 + q] + part[(wb + 1) * 2 + q]) + (part[(wb + 2) * 2 + q] + part[(wb + 3) * 2 + q]);
            const float rs = 1.0f / sqrtf(tot * (1.0f / 256.0f) + EPS);
            WSP(bf16, WS_MIX)[row * DM + 1024 + ch] = (bf16)f2bf(v[q] * rs * p.in[14][ch]); }
    }
    }
    __syncthreads();
}

__device__ __forceinline__ void scan_phase(const Params& p, const Ctx& F) {
    const int gt = blockIdx.x * 512 + F.tid, NT = gridDim.x * 512;
    for (int idx = gt; idx < 131072; idx += NT) {
        const int n2 = idx & 63, pp = (idx >> 6) & 63, hh = (idx >> 12) & 15, b = idx >> 16;
        float s0 = 0.f, s1 = 0.f;
#pragma unroll 1
        for (int c0 = 0; c0 < 64; c0 += 8) {
            unsigned st[8]; float dc[8];
#pragma unroll
            for (int k = 0; k < 8; ++k) { const size_t off = ((size_t)((b * 64 + c0 + k) * 16 + hh) * 64 + pp) * 128 + 2 * n2;
                st[k] = *(const unsigned*)((const bf16*)(p.out + OS_STATES) + off); dc[k] = WSP(float, WS_DEC)[(b * 64 + c0 + k) * 16 + hh]; }
#pragma unroll
            for (int k = 0; k < 8; ++k) { const size_t off = ((size_t)((b * 64 + c0 + k) * 16 + hh) * 64 + pp) * 128 + 2 * n2;
                *(unsigned*)(((bf16*)(p.out + OS_PREV)) + off) = pk2(s0, s1);
                s0 = s0 * dc[k] + bflo(st[k]); s1 = s1 * dc[k] + bfhi(st[k]); }
        }
        f32x2 fin; fin[0] = s0; fin[1] = s1;
        *(f32x2*)(p.out + O_SSMP + ((size_t)(b * 16 + hh) * 64 + pp) * 128 + 2 * n2) = fin;
    }
}


template <bool DIAG> __device__ __forceinline__ void ssd_jb(f32x16 (&acc)[2], const f32x16& cb, int jb, const float* cslh, float cs_i, float ddt, int irel, int hi, const bf16* XdTh, int swb) {
    const int l31 = threadIdx.x & 31;
#pragma unroll
    for (int s = 0; s < 2; ++s) {
        float mv[8];
#pragma unroll
        for (int t = 0; t < 8; ++t) { const int r = 8 * s + t, jj = crow(r, hi);
            float m = cb[r] * fexp(cs_i - cslh[32 * jb + jj]);
            if (DIAG) { m = (jj <= irel) ? m : 0.f; m += (jj == irel) ? ddt : 0.f; }
            mv[t] = m; }
        u32x4 mw; mw.x = pk2(mv[0], mv[1]); mw.y = pk2(mv[2], mv[3]); mw.z = pk2(mv[4], mv[5]); mw.w = pk2(mv[6], mv[7]);
        const bf16x8 mf = __builtin_bit_cast(bf16x8, mw);
        const int kb = 32 * jb + 16 * s + 4 * hi;
#pragma unroll
        for (int pb = 0; pb < 2; ++pb) { const bf16* xr = XdTh + (32 * pb + l31) * 136; const int sw = (swb + 4 * pb + (l31 >> 3)) & 15, q0 = kb >> 2;
            const u32x2 lo = *(const u32x2*)(xr + 4 * (q0 ^ sw)), h2 = *(const u32x2*)(xr + 4 * ((q0 + 2) ^ sw)); const u32x4 xw = {lo.x, lo.y, h2.x, h2.y};
            acc[pb] = MFMA32(__builtin_bit_cast(bf16x8, xw), mf, acc[pb]); }
    }
}

__device__ __forceinline__ void ssdy_unit(const Params& p, const Ctx& F, int unit, unsigned char* lds) {
    const int tid = F.tid, lane = F.lane, wid = F.wid, l31 = lane & 31, hi = lane >> 5;
    const int g = unit & 3, c = (unit >> 2) & 63, b = unit >> 8;
    bf16* Cs = (bf16*)lds;
    bf16* Bs = (bf16*)(lds + 34816);
    bf16* XdT = (bf16*)(lds + 34816);
    float* csl = (float*)(lds + 104448);
    float* dtl = csl + 512;
    float* red = dtl + 512;
    const long tokc = (long)b * SEQ + c * 128;
    chunk_cumsum(p, F, tokc, g, csl, dtl, nullptr);
#pragma unroll 1
    for (int ps = 0; ps < 4; ++ps) {
        const int which = ps >> 1, chunk = tid & 31, tg = (tid >> 5) + 16 * (ps & 1);
        float o[4][4];
        conv4x4(p, tokc, c, 4 * tg, 1024 + 512 * which + 128 * g + chunk * 4, o);
        bf16* dst = (which ? Cs : Bs) + (4 * tg) * 136 + chunk * 4;
#pragma unroll
        for (int q = 0; q < 4; ++q) { u32x2 w; w.x = pk2(o[q][0], o[q][1]); w.y = pk2(o[q][2], o[q][3]); *(u32x2*)(dst + q * 136) = w; }
    }
    __syncthreads();
    const int ib = wid & 3, hp = wid >> 2;
    f32x16 CBt[4];
#pragma unroll
    for (int jb = 0; jb < 4; ++jb) {
        CBt[jb] = (f32x16){0.f, 0.f, 0.f, 0.f, 0.f, 0.f, 0.f, 0.f, 0.f, 0.f, 0.f, 0.f, 0.f, 0.f, 0.f, 0.f};
        if (jb <= ib) {
#pragma unroll
            for (int ks = 0; ks < 8; ++ks) {
                const bf16x8 bfr = *(const bf16x8*)(Bs + (32 * jb + l31) * 136 + 16 * ks + 8 * hi);
                const bf16x8 cfr = *(const bf16x8*)(Cs + (32 * ib + l31) * 136 + 16 * ks + 8 * hi);
                CBt[jb] = MFMA32(bfr, cfr, CBt[jb]);
            }
        }
    }
    __syncthreads();
#pragma unroll 1
    for (int ps = 0; ps < 4; ++ps) {
        const int chunk = tid & 63, tg = (tid >> 6) + 8 * ps, hl = chunk >> 4;
        float o[4][4];
        conv4x4(p, tokc, c, 4 * tg, 256 * g + chunk * 4, o);
        const f32x4 dv = *(const f32x4*)(dtl + hl * 128 + 4 * tg);
        store_t4(XdT, chunk * 4, tg, o, dv[0], dv[1], dv[2], dv[3]);
    }
    __syncthreads();
    const int i = 32 * ib + l31;
    const size_t tok = (size_t)(tokc + i);
    float sq = 0.f;
#pragma unroll 1
    for (int hh2 = 0; hh2 < 2; ++hh2) {
        const int hl = 2 * hp + hh2, hg = 4 * g + hl;
        int l31h = l31; asm volatile("" : "+v"(l31h));
        const float cs_i = csl[hl * 128 + i], ddt = p.in[13][hg] / dtl[hl * 128 + i], e_i = fexp(cs_i);
        f32x16 acc[2];
        acc[0] = (f32x16){0.f, 0.f, 0.f, 0.f, 0.f, 0.f, 0.f, 0.f, 0.f, 0.f, 0.f, 0.f, 0.f, 0.f, 0.f, 0.f}; acc[1] = acc[0];
        const bf16* pv = ((bf16*)(p.out + OS_PREV)) + ((size_t)((b * 64 + c) * 16 + hg) * 64) * 128;
#pragma unroll
        for (int ks = 0; ks < 8; ++ks) {
            const bf16x8 cfr = *(const bf16x8*)(Cs + (32 * ib + l31) * 136 + 16 * ks + 8 * hi);
#pragma unroll
            for (int pb = 0; pb < 2; ++pb) { const bf16x8 pf = *(const bf16x8*)(pv + (size_t)(32 * pb + l31) * 128 + 16 * ks + 8 * hi); acc[pb] = MFMA32(pf, cfr, acc[pb]); }
            if ((ks & 3) == 3) asm volatile("" ::: "memory");
        }
#pragma unroll
        for (int pb = 0; pb < 2; ++pb)
#pragma unroll
            for (int r = 0; r < 16; ++r) acc[pb][r] *= e_i;
#pragma unroll
        for (int jb = 0; jb < 4; ++jb) {
            if (jb <= ib) ssd_jb<true>(acc, CBt[jb], jb, csl + hl * 128, cs_i, ddt, l31h + 32 * (ib - jb), hi, XdT + (hl * 64) * 136, (hl & 1) * 8);
        }
        const bf16* zr = WSP(bf16, WS_PROJ) + tok * LDP + C_Z + hg * 64;
        bf16* orow = WSP(bf16, WS_MIX) + tok * DM + 1024 + hg * 64;
        u32x2 zv[2][4];
#pragma unroll
        for (int pb = 0; pb < 2; ++pb)
#pragma unroll
            for (int rg = 0; rg < 4; ++rg) zv[pb][rg] = *(const u32x2*)(zr + 32 * pb + 8 * rg + 4 * hi);
#pragma unroll
        for (int pb = 0; pb < 2; ++pb)
#pragma unroll
            for (int rg = 0; rg < 4; ++rg) {
                const int d = 32 * pb + 8 * rg + 4 * hi;
                const u32x2 zw = zv[pb][rg];
                const float v0 = acc[pb][4 * rg + 0] * silu_f(bflo(zw.x)), v1 = acc[pb][4 * rg + 1] * silu_f(bfhi(zw.x));
                const float v2 = acc[pb][4 * rg + 2] * silu_f(bflo(zw.y)), v3 = acc[pb][4 * rg + 3] * silu_f(bfhi(zw.y));
                u32x2 w; w.x = pk2(v0, v1); w.y = pk2(v2, v3);
                const float q0 = bflo(w.x), q1 = bfhi(w.x), q2 = bflo(w.y), q3 = bfhi(w.y);
                sq += (q0 * q0 + q1 * q1) + (q2 * q2 + q3 * q3);
                *(u32x2*)(orow + d) = w;
            }
    }
    sq += __shfl_xor(sq, 32);
    if (hi == 0) red[hp * 128 + i] = sq;
    __syncthreads();
    const float rs = 1.0f / sqrtf((red[i] + red[128 + i]) * (1.0f / 256.0f) + EPS);
#pragma unroll 1
    for (int hh2 = 0; hh2 < 2; ++hh2) {
        const int hg = 4 * g + 2 * hp + hh2;
        const float* gn = p.in[14] + hg * 64;
        bf16* orow = WSP(bf16, WS_MIX) + tok * DM + 1024 + hg * 64;
        f32x4 gvv[2][4]; u32x2 wv[2][4];
#pragma unroll
        for (int pb = 0; pb < 2; ++pb)
#pragma unroll
            for (int rg = 0; rg < 4; ++rg) { const int d = 32 * pb + 8 * rg + 4 * hi; gvv[pb][rg] = *(const f32x4*)(gn + d); wv[pb][rg] = *(const u32x2*)(orow + d); }
#pragma unroll
        for (int pb = 0; pb < 2; ++pb)
#pragma unroll
            for (int rg = 0; rg < 4; ++rg) {
                const int d = 32 * pb + 8 * rg + 4 * hi; const f32x4 gv = gvv[pb][rg];
                const u32x2 w0 = wv[pb][rg];
                u32x2 w; w.x = pk2(bflo(w0.x) * rs * gv[0], bfhi(w0.x) * rs * gv[1]); w.y = pk2(bflo(w0.y) * rs * gv[2], bfhi(w0.y) * rs * gv[3]);
                *(u32x2*)(orow + d) = w;
            }
    }
    __syncthreads();
}


#define MFMA16(a, b, c) __builtin_amdgcn_mfma_f32_16x16x32_bf16((a), (b), (c), 0, 0, 0)
template <int NB> __device__ __forceinline__ void skinny_acc(f32x4 (&res)[NB], const bf16* A, int lda, const bf16* B0, const bf16* B1, int ldb, int K, unsigned char* lds, const Ctx& F) {
    const int lane = F.lane, wid = F.wid, fr = lane & 15, fq = lane >> 4;
    const int kper = K >> 3;
    f32x4 acc[NB][4];
#pragma unroll
    for (int nb = 0; nb < NB; ++nb)
#pragma unroll
        for (int m = 0; m < 4; ++m) acc[nb][m] = (f32x4){0.f, 0.f, 0.f, 0.f};
    const bf16* ap = A + (size_t)fr * lda + wid * kper + 8 * fq;
    const bf16* bp0 = B0 + (size_t)fr * ldb + wid * kper + 8 * fq;
    const bf16* bp1 = B1 + (size_t)fr * ldb + wid * kper + 8 * fq;
#pragma unroll 4
    for (int k = 0; k < kper; k += 32) {
        const bf16x8 b0 = *(const bf16x8*)(bp0 + k);
        bf16x8 b1 = b0; if (NB == 2) b1 = *(const bf16x8*)(bp1 + k);
#pragma unroll
        for (int m = 0; m < 4; ++m) { const bf16x8 a = *(const bf16x8*)(ap + (size_t)(16 * m) * lda + k);
            acc[0][m] = MFMA16(b0, a, acc[0][m]); if (NB == 2) acc[NB - 1][m] = MFMA16(b1, a, acc[NB - 1][m]); }
    }
    f32x4* red = (f32x4*)lds;
#pragma unroll
    for (int nb = 0; nb < NB; ++nb)
#pragma unroll
        for (int m = 0; m < 4; ++m) red[((wid * NB + nb) * 4 + m) * 64 + lane] = acc[nb][m];
    __syncthreads();
    if (F.tid < 256) {
#pragma unroll
        for (int nb = 0; nb < NB; ++nb) { f32x4 s = {0.f, 0.f, 0.f, 0.f};
#pragma unroll
            for (int w = 0; w < 8; ++w) s = s + red[((w * NB + nb) * 4 + wid) * 64 + lane];
            res[nb] = s; }
    }
}
__device__ __forceinline__ void s1_unit(const Params& p, const Ctx& F, int unit, unsigned char* lds) {
    const int rh = unit & 1, c0 = (unit >> 1) * 16, fr = F.lane & 15, fq = F.lane >> 4;
    f32x4 v[1];
    skinny_acc<1>(v, WSP(bf16, WS_U) + (size_t)(16384 + 64 * rh) * DM, DM, WSP(bf16, WS_WIN) + (size_t)c0 * DM, nullptr, DM, DM, lds, F);
    if (F.tid < 256) {
        const size_t row = 16384 + 64 * rh + 16 * F.wid + fr;
        f32x4 x = v[0] * WSP(float, WS_R0)[row];
        if (c0 < 1280 && (c0 & 63) == 0) {
            const float* t = WSP(float, WS_TAB) + (size_t)8192 * 16 + 4 * (fq & 1);
            const f32x4 cs = *(const f32x4*)t, sn = *(const f32x4*)(t + 8);
            f32x4 o;
#pragma unroll
            for (int j = 0; j < 4; ++j) o[j] = __shfl_xor(x[j], 32);
            x = (fq < 2) ? (x * cs - o * sn) : (x * cs + o * sn);
        }
        u32x2 w; w.x = pk2(x[0], x[1]); w.y = pk2(x[2], x[3]);
        *(u32x2*)(WSP(bf16, WS_PROJ) + row * LDP + c0 + 4 * fq) = w;
        if (c0 == C_DT) { const float* bb = p.in[11] + 4 * fq; f32x4 d;
#pragma unroll
            for (int j = 0; j < 4; ++j) d[j] = pg8::softplus_f(x[j] + bb[j]);
            *(f32x4*)(WSP(float, WS_DT) + row * 16 + 4 * fq) = d; }
    }
    __syncthreads();
}
__device__ __forceinline__ void s_res_epilogue(const Params& p, const Ctx& F, f32x4 v, f32x4 base, size_t row, int c, float* ss) {
    const f32x4 h = base + v;
    u32x2 w; w.x = pk2(h[0], h[1]); w.y = pk2(h[2], h[3]);
    *(u32x2*)(WSP(bf16, WS_U) + row * DM + c) = w;
    float sq = (h[0] * h[0] + h[1] * h[1]) + (h[2] * h[2] + h[3] * h[3]);
    sq += __shfl_xor(sq, 16); sq += __shfl_xor(sq, 32);
    if ((F.lane >> 4) == 0) atomicAdd(ss + row, sq);
}
__device__ __forceinline__ void s2_unit(const Params& p, const Ctx& F, int unit, unsigned char* lds) {
    const int rh = unit & 1, c0 = (unit >> 1) * 16, fr = F.lane & 15, fq = F.lane >> 4;
    f32x4 v[1];
    skinny_acc<1>(v, WSP(bf16, WS_MIX) + (size_t)(16384 + 64 * rh) * DM, DM, WSP(bf16, WS_WO) + (size_t)c0 * DM, nullptr, DM, DM, lds, F);
    if (F.tid < 256) { const size_t srow = 64 * rh + 16 * F.wid + fr; const int c = c0 + 4 * fq;
        const u32x2 hb = *(const u32x2*)(WSP(bf16, WS_U) + (16384 + srow) * DM + c);
        s_res_epilogue(p, F, v[0], (f32x4){bflo(hb.x), bfhi(hb.x), bflo(hb.y), bfhi(hb.y)}, 16384 + srow, c, WSP(float, WS_SS1)); }
    __syncthreads();
}
__device__ __forceinline__ void s3_unit(const Params& p, const Ctx& F, int unit, unsigned char* lds) {
    const int rh = unit & 1, hc0 = (unit >> 1) * 16, fr = F.lane & 15, fq = F.lane >> 4;
    const bf16* Bg = WSP(bf16, WS_WGU) + (size_t)((hc0 >> 7) * 256 + (hc0 & 127)) * DM;
    f32x4 v[2];
    skinny_acc<2>(v, WSP(bf16, WS_U) + (size_t)(16384 + 64 * rh) * DM, DM, Bg, Bg + (size_t)128 * DM, DM, DM, lds, F);
    if (F.tid < 256) { const size_t row = 16384 + 64 * rh + 16 * F.wid + fr;
        const float r = 1.0f / sqrtf(WSP(float, WS_SS1)[row] * (1.0f / DM) + EPS);
        f32x4 h;
#pragma unroll
        for (int j = 0; j < 4; ++j) { const float g = v[0][j] * r; h[j] = g * pg8::sigmoid_f(g) * (v[1][j] * r); }
        u32x2 w; w.x = pk2(h[0], h[1]); w.y = pk2(h[2], h[3]);
        *(u32x2*)(WSP(bf16, WS_PROJ) + row * FF + hc0 + 4 * fq) = w; }
    __syncthreads();
}
__device__ __forceinline__ void s4_unit(const Params& p, const Ctx& F, int unit, unsigned char* lds) {
    const int rh = unit & 1, c0 = (unit >> 1) * 16, fr = F.lane & 15, fq = F.lane >> 4;
    f32x4 v[1];
    skinny_acc<1>(v, WSP(bf16, WS_PROJ) + (size_t)(16384 + 64 * rh) * FF, FF, WSP(bf16, WS_WD) + (size_t)c0 * FF, nullptr, FF, FF, lds, F);
    if (F.tid < 256) { const size_t row = 16384 + 64 * rh + 16 * F.wid + fr; const int c = c0 + 4 * fq;
        const u32x2 hb = *(const u32x2*)(WSP(bf16, WS_U) + row * DM + c);
        s_res_epilogue(p, F, v[0], (f32x4){bflo(hb.x), bfhi(hb.x), bflo(hb.y), bfhi(hb.y)}, row, c, WSP(float, WS_SS2)); }
    __syncthreads();
}
__device__ __forceinline__ void s5_unit(const Params& p, const Ctx& F, int unit, unsigned char* lds) {
    const int rh = unit & 1, c0 = (unit >> 1) * 16, fr = F.lane & 15, fq = F.lane >> 4;
    f32x4 vg[1], vp[1];
    skinny_acc<1>(vg, WSP(bf16, WS_U) + (size_t)(16384 + 64 * rh) * DM, DM, WSP(bf16, WS_WPG) + (size_t)c0 * DM, nullptr, DM, DM, lds, F);
    __syncthreads();
    skinny_acc<1>(vp, WSP(bf16, WS_PB) + (size_t)(16384 + 64 * rh) * 256, 256, WSP(bf16, WS_WP) + (size_t)c0 * 256, nullptr, 256, 256, lds, F);
    if (F.tid < 256) { const size_t row = 16384 + 64 * rh + 16 * F.wid + fr;
        const float r = 1.0f / sqrtf(WSP(float, WS_SS2)[row] * (1.0f / DM) + EPS);
        const size_t ho = row * DM + c0 + 4 * fq;
        const u32x2 hb = *(const u32x2*)(WSP(bf16, WS_U) + ho);
        f32x4 h = {bflo(hb.x), bfhi(hb.x), bflo(hb.y), bfhi(hb.y)};
#pragma unroll
        for (int j = 0; j < 4; ++j) h[j] += vp[0][j] * pg8::sigmoid_f(vg[0][j] * r);
        u32x2 w; w.x = pk2(h[0], h[1]); w.y = pk2(h[2], h[3]);
        *(u32x2*)(WSP(bf16, WS_H3) + ho) = w; }
    __syncthreads();
}

template <int WGM_ = 4, class Epi> __device__ __forceinline__ void run_gemm(PG8_LAS unsigned char* lds, const bf16* A, const bf16* Bt, int M, int N, int K, const Epi& E) {
    pg8::Gemm g{A, Bt, M, N, K}; pg8::StaticOrder S; S.init(M, N, (int)gridDim.x, (int)blockIdx.x, WGM_);
    pg8::gemm_phase<Epi, pg8::StaticOrder, true, true>(lds, g, S, E);
}

#ifndef PHMASK
#define PHMASK 0xffff
#endif
constexpr int LDS_BYTES = 147456;
__global__ void __launch_bounds__(512, 2) mega_fwd(Params p) {
    extern __shared__ __attribute__((aligned(16))) unsigned char lds[];
    cg::grid_group grid = cg::this_grid();
    PG8_LAS unsigned char* lds3 = (PG8_LAS unsigned char*)lds;
    const int G = gridDim.x;
    volatile LAS unsigned* MISC = (volatile LAS unsigned*)(lds3 + 131072 + 320);
    if (threadIdx.x < 32) MISC[threadIdx.x] = 0u;
    unsigned* barw = (unsigned*)(p.ws + WS_BAR);
    unsigned* readyw = barw + XCD_BAR_WORDS + 64;
    constexpr unsigned RDY = 0x13579BDFu, DONE = 0x2468ACE0u;
    if (blockIdx.x == 0) {
        for (int i = threadIdx.x; i < XCD_BAR_WORDS; i += 512) barw[i] = 0u;
        asm volatile("s_waitcnt vmcnt(0)" ::: "memory");
        __syncthreads();
        if (threadIdx.x == 0) { __builtin_amdgcn_fence(__ATOMIC_RELEASE, "agent"); asm volatile("s_waitcnt vmcnt(0)" ::: "memory"); __hip_atomic_store(readyw, RDY, __ATOMIC_RELAXED, __HIP_MEMORY_SCOPE_AGENT); }
    }
    __syncthreads();

    if (PHMASK & 1) { const Ctx F = mk_ctx(); p0_prologue(p, F, lds); }
    if (p.ws == nullptr) grid.sync();
    if (threadIdx.x == 0) {
        unsigned sp = 0u;
        while (__hip_atomic_load(readyw, __ATOMIC_RELAXED, __HIP_MEMORY_SCOPE_AGENT) != RDY) { __builtin_amdgcn_s_sleep(2); if (++sp > (1u << 22)) break; }
        __builtin_amdgcn_fence(__ATOMIC_ACQUIRE, "agent");
    }
    __syncthreads();
    const XcdBarrier xbar = xcd_barrier_post(barw, MISC + 8);
    xcd_barrier(xbar);
    if (PHMASK & 2) { pg8::EpiProj E{WSP(bf16, WS_PROJ), WSP(float, WS_DT), WSP(float, WS_TAB), p.in[11], WSP(float, WS_R0)}; run_gemm(lds3, WSP(bf16, WS_U), WSP(bf16, WS_WIN), 16384, LDP, 2048, E); }
    { const Ctx F = mk_ctx(); const bool bal = (G == 256);
      if (!bal || blockIdx.x >= 192) for (int it = bal ? (int)blockIdx.x - 192 : (int)blockIdx.x; it < 578; it += (bal ? 64 : G)) s1_unit(p, F, it, lds); }
    xcd_barrier(xbar);
#pragma unroll 1
    for (int stage = 0; stage < 3; ++stage) {
        const bool late = (G == 256) && (blockIdx.x < 128);
        const int kind = late ? (stage == 2 ? 0 : stage + 1) : stage;
        const Ctx F = mk_ctx();
        if (kind == 0) { for (int it = blockIdx.x; it < 256; it += G) sample_unit(p, F, it & 127, it >> 7, lds); }
        else if (kind == 1) { for (int it = blockIdx.x; it < 512; it += G) attn_unit(p, F, it, lds); }
        else { for (int it = blockIdx.x; it < 512; it += G) state_unit(p, F, it, lds); }
    }
    { const Ctx F = mk_ctx(); const int gt = blockIdx.x * 512 + F.tid, NT = G * 512;
    for (int i = gt; i < 2 * 128 * 512; i += NT) {
        const int col = i & 511, w = (i >> 9) & 127, b = i >> 16;
        const float v = bf2f(WSP(bf16, WS_PROJ)[(size_t)(b * SEQ + SEQ - 128 + w) * LDP + C_K + col]);
        if (col < 256) p.out[O_KP + (size_t)(b * 128 + w) * 256 + col] = v; else p.out[O_VP + (size_t)(b * 128 + w) * 256 + (col - 256)] = v;
    }
    for (int i = gt; i < 2 * 3 * 2048; i += NT) {
        const int ch = i & 2047, t = (i >> 11) % 3, b = i / 6144;
        p.out[O_CONVP + i] = bf2f(WSP(bf16, WS_PROJ)[(size_t)(b * SEQ + SEQ - 3 + t) * LDP + C_X + ch]);
    }
    }
    xcd_barrier(xbar);
    if (PHMASK & 8) { const Ctx F = mk_ctx(); scan_phase(p, F); for (int it = blockIdx.x; it < 256; it += G) s2_unit(p, F, it, lds); }
    xcd_barrier(xbar);
    if (PHMASK & 16) { const Ctx F = mk_ctx(); for (int it = blockIdx.x; it < 512; it += G) ssdy_unit(p, F, it, lds); }
    { const Ctx F = mk_ctx(); for (int it = blockIdx.x; it < 704; it += G) s3_unit(p, F, it, lds); }
    xcd_barrier(xbar);
    if (PHMASK & 32) { pg8::EpiRes<false> E{nullptr, WSP(bf16, WS_U), WSP(float, WS_SS1)}; run_gemm(lds3, WSP(bf16, WS_MIX), WSP(bf16, WS_WO), 16384, 2048, 2048, E); }
    { const Ctx F = mk_ctx(); for (int it = blockIdx.x; it < 256; it += G) s4_unit(p, F, it, lds); }
    xcd_barrier(xbar);
    if (PHMASK & 64) { pg8::EpiGateUp E{WSP(bf16, WS_PROJ), WSP(float, WS_SS1)}; run_gemm<8>(lds3, WSP(bf16, WS_U), WSP(bf16, WS_WGU), 16384, 2 * FF, 2048, E); }
    xcd_barrier(xbar);
    if (PHMASK & 128) { pg8::EpiRes<false> E{nullptr, WSP(bf16, WS_U), WSP(float, WS_SS2)}; run_gemm(lds3, WSP(bf16, WS_PROJ), WSP(bf16, WS_WD), 16384, 2048, FF, E); }
    if (PHMASK & 0x8000) { pg8::EpiPlain E{WSP(bf16, WS_MIX)}; int Kq = 256; asm volatile("" : "+s"(Kq)); run_gemm(lds3, WSP(bf16, WS_PB), WSP(bf16, WS_WP), 16384, 2048, Kq, E); }
    { const Ctx F = mk_ctx(); for (int it = blockIdx.x; it < 256; it += G) s5_unit(p, F, it, lds); }
    xcd_barrier(xbar);
    if (PHMASK & 256) { pg8::EpiPle E{WSP(bf16, WS_U), WSP(bf16, WS_H3), WSP(bf16, WS_MIX), WSP(float, WS_SS2)}; run_gemm(lds3, WSP(bf16, WS_U), WSP(bf16, WS_WPG), 16384, 2048, 2048, E); }
    xcd_barrier(xbar);
    {
        const Ctx F = mk_ctx();
        const float* gf = p.in[25];
        for (int m = blockIdx.x * 8 + F.wid; m < MREAL; m += G * 8) {
            const u32x4* hb = (const u32x4*)(WSP(bf16, WS_H3) + (size_t)m * DM);
            f32x4* yr = (f32x4*)(p.out + O_Y + (size_t)m * DM);
            u32x4 w[4]; float s = 0.f;
#pragma unroll
            for (int j = 0; j < 4; ++j) { w[j] = hb[F.lane + 64 * j];
                const float a0 = bflo(w[j].x), a1 = bfhi(w[j].x), a2 = bflo(w[j].y), a3 = bfhi(w[j].y), a4 = bflo(w[j].z), a5 = bfhi(w[j].z), a6 = bflo(w[j].w), a7 = bfhi(w[j].w);
                s += ((a0 * a0 + a1 * a1) + (a2 * a2 + a3 * a3)) + ((a4 * a4 + a5 * a5) + (a6 * a6 + a7 * a7)); }
            const float rstd = 1.0f / sqrtf(wave_sum(s) * (1.0f / DM) + EPS);
#pragma unroll
            for (int j = 0; j < 4; ++j) { const int c8 = F.lane + 64 * j; const f32x4 g0 = ((const f32x4*)gf)[2 * c8], g1 = ((const f32x4*)gf)[2 * c8 + 1];
                yr[2 * c8] = (f32x4){bflo(w[j].x), bfhi(w[j].x), bflo(w[j].y), bfhi(w[j].y)} * rstd * g0;
                yr[2 * c8 + 1] = (f32x4){bflo(w[j].z), bfhi(w[j].z), bflo(w[j].w), bfhi(w[j].w)} * rstd * g1; }
        }
    }
    if (blockIdx.x == 0 && threadIdx.x == 0) __hip_atomic_store(readyw, DONE, __ATOMIC_RELAXED, __HIP_MEMORY_SCOPE_AGENT);
}

extern "C" void kernel_launch(void* const* d_in, const int* in_sizes, int n_in, void* d_out, int out_size, void* d_ws, size_t ws_size, hipStream_t stream) {
    static int grid = 0;
    if (grid == 0) {
        if (n_in != 26 || ws_size < WS_END) { fprintf(stderr, "kernel_launch: unexpected n_in %d / ws_size %zu (need %zu)\n", n_in, ws_size, (size_t)WS_END); grid = -1; return; }
        int dev = 0, cus = 0, per_cu = 0;
        hipGetDevice(&dev);
        hipDeviceGetAttribute(&cus, hipDeviceAttributeMultiprocessorCount, dev);
        hipFuncSetAttribute((const void*)mega_fwd, hipFuncAttributeMaxDynamicSharedMemorySize, LDS_BYTES);
        if (hipOccupancyMaxActiveBlocksPerMultiprocessor(&per_cu, (const void*)mega_fwd, 512, LDS_BYTES) != hipSuccess || per_cu < 1) per_cu = 1;
        (void)hipGetLastError();
        grid = cus * per_cu;
        if (grid > 256) grid = 256;
    }
    if (grid < 0) return;
    Params p{};
    for (int i = 0; i < 26; ++i) p.in[i] = (const float*)d_in[i];
    p.out = (float*)d_out; p.ws = (unsigned char*)d_ws;
    void* args[] = {&p};
    hipError_t e = hipLaunchCooperativeKernel((const void*)mega_fwd, dim3(grid), dim3(512), args, LDS_BYTES, stream);
    if (e != hipSuccess) fprintf(stderr, "cooperative launch failed: %s (grid %d)\n", hipGetErrorString(e), grid);
}
```
